# Optimizing an MI355X kernel written in HIP

```python
import jax, jax.numpy as jnp
from jax import lax
import numpy as np

D_MODEL = 2048
BATCH = 4
SEQ = 4096
DEPTH = 2
DEC_BATCH = 16
DEC_SEQ = 16
PAST_LEN = 2048

CHUNK = 64
Q_BLOCK = 128
MLA_HEADS = 8
QK_NOPE = 128
QK_ROPE = 64
V_HEAD = 128
Q_LORA = 512
KV_LORA = 512
MLA_QK = QK_NOPE + QK_ROPE
MLA_SCALE = MLA_QK ** -0.5
RET_HEADS = 8
RET_DK = 128
RET_DV = 256
RET_QK_W = RET_HEADS * RET_DK
RET_V_W = RET_HEADS * RET_DV
RET_K_SCALE = RET_DK ** -0.5
D_FF = 5632
ROPE_THETA = 10000.0
NORM_EPS = 1e-6
GN_EPS = 1e-5
IN_WIDTH = Q_LORA + KV_LORA + QK_ROPE + 2 * RET_QK_W + 2 * RET_V_W + 2 * D_MODEL

kernel_name = "mla_retention_gated_macaron_stream_step"


def _in_offsets():
    sizes = (Q_LORA, KV_LORA, QK_ROPE, RET_QK_W, RET_QK_W, RET_V_W, RET_V_W, D_MODEL, D_MODEL)
    offs, acc = [], 0
    for s in sizes[:-1]:
        acc += s
        offs.append(acc)
    return offs


def rms_norm(x, g):
    xf = x.astype(jnp.float32)
    y = xf * lax.rsqrt(jnp.mean(xf * xf, axis=-1, keepdims=True) + NORM_EPS)
    return (y * g.astype(jnp.float32)).astype(x.dtype)


def head_group_norm(x):
    xf = x.astype(jnp.float32)
    mu = jnp.mean(xf, axis=-1, keepdims=True)
    var = jnp.mean(jnp.square(xf - mu), axis=-1, keepdims=True)
    return (xf - mu) * lax.rsqrt(var + GN_EPS)


def swiglu(x, w13, w2):
    a, b = jnp.split(x @ w13, 2, axis=-1)
    return (jax.nn.silu(a) * b) @ w2


def rope(x, pos):
    d = x.shape[-1]
    inv = ROPE_THETA ** (-jnp.arange(0, d, 2, dtype=jnp.float32) / d)
    ang = pos.astype(jnp.float32)[:, None] * inv[None, :]
    shape = (pos.shape[0],) + (1,) * (x.ndim - 3) + (d // 2,)
    cos = jnp.cos(ang).reshape(shape)
    sin = jnp.sin(ang).reshape(shape)
    xf = x.astype(jnp.float32)
    x1, x2 = xf[..., : d // 2], xf[..., d // 2:]
    return jnp.concatenate([x1 * cos - x2 * sin, x2 * cos + x1 * sin], axis=-1).astype(x.dtype)


def mla_prompt(q_nope, q_rope, c, kr, pos, w_uk, w_uv):
    B, T, H, _ = q_nope.shape
    nb = T // Q_BLOCK
    k_nope = jnp.einsum('bkr,rhd->bkhd', c, w_uk)
    v = jnp.einsum('bkr,rhd->bkhd', c, w_uv)
    chunk_id = pos // CHUNK

    def block(args):
        qn, qr, qc = args
        s = (jnp.einsum('bqhd,bkhd->bhqk', qn, k_nope)
             + jnp.einsum('bqhe,bke->bhqk', qr, kr)).astype(jnp.float32) * MLA_SCALE
        mask = chunk_id[None, :] <= qc[:, None]
        p = jax.nn.softmax(jnp.where(mask[None, None], s, -jnp.inf), axis=-1).astype(v.dtype)
        return jnp.einsum('bhqk,bkhd->bqhd', p, v)

    def to_blocks(a):
        return jnp.moveaxis(a.reshape((B, nb, Q_BLOCK) + a.shape[2:]), 1, 0)

    out = lax.map(block, (to_blocks(q_nope), to_blocks(q_rope), chunk_id.reshape(nb, Q_BLOCK)))
    return jnp.moveaxis(out, 0, 1).reshape(B, T, H, V_HEAD)


def mla_sample(q_nope, q_rope, c_all, kr_all, w_uk, w_uv):
    q_lat = jnp.einsum('bqhd,rhd->bqhr', q_nope, w_uk)
    s = (jnp.einsum('bqhr,bkr->bhqk', q_lat, c_all)
         + jnp.einsum('bqhe,bke->bhqk', q_rope, kr_all)).astype(jnp.float32) * MLA_SCALE
    p = jax.nn.softmax(s, axis=-1).astype(c_all.dtype)
    o_lat = jnp.einsum('bhqk,bkr->bqhr', p, c_all)
    return jnp.einsum('bqhr,rhd->bqhd', o_lat, w_uv)


def retention(q, k, v, s0):
    B, T, H, _ = q.shape
    cs = min(CHUNK, T)
    n = T // cs
    lg = jnp.log1p(-jnp.exp2(-5.0 - jnp.arange(H, dtype=jnp.float32)))
    j = jnp.arange(cs, dtype=jnp.float32)
    diff = j[:, None] - j[None, :]
    dmask = jnp.where(diff[None] >= 0, jnp.exp(jnp.maximum(diff, 0.0)[None] * lg[:, None, None]), 0.0)
    q_dec = jnp.exp((j + 1.0)[None] * lg[:, None])[..., None]
    k_dec = jnp.exp((cs - 1.0 - j)[None] * lg[:, None])[..., None]
    c_dec = jnp.exp(cs * lg)[:, None, None]

    def to_chunks(a):
        a = a.astype(jnp.float32)
        return a.reshape(B, n, cs, H, a.shape[-1]).transpose(1, 0, 3, 2, 4)

    def step(S, inp):
        qc, kc, vc = inp
        att = jnp.einsum('bhid,bhjd->bhij', qc, kc) * dmask
        o = jnp.einsum('bhij,bhje->bhie', att, vc) + jnp.einsum('bhid,bhde->bhie', qc * q_dec, S)
        S = S * c_dec + jnp.einsum('bhjd,bhje->bhde', kc * k_dec, vc)
        return S, o

    S, o = lax.scan(step, s0.astype(jnp.float32), (to_chunks(q), to_chunks(k), to_chunks(v)))
    o = o.transpose(1, 0, 3, 2, 4).reshape(B, T, H, v.shape[-1])
    return o, S


def trunk_layer(x, pos, past_c, past_kr, ret_s0, ffn1_norm, ffn1_w13, ffn1_w2, mix_norm, w_in,
                q_norm, kv_norm, w_uq, w_uk, w_uv, w_mla_out, w_ret_out, w_out,
                ffn2_norm, ffn2_w13, ffn2_w2):
    B, T, _ = x.shape
    x = x + 0.5 * swiglu(rms_norm(x, ffn1_norm), ffn1_w13, ffn1_w2)
    u = rms_norm(x, mix_norm)
    q_lat, c_kv, k_r, r_q, r_k, r_v, r_g, g_mla, g_ret = jnp.split(u @ w_in, _in_offsets(), axis=-1)
    q = (rms_norm(q_lat, q_norm) @ w_uq).reshape(B, T, MLA_HEADS, MLA_QK)
    q_nope = q[..., :QK_NOPE]
    q_rope = rope(q[..., QK_NOPE:], pos)
    c_kv = rms_norm(c_kv, kv_norm)
    k_r = rope(k_r, pos)
    if past_c is None:
        a = mla_prompt(q_nope, q_rope, c_kv, k_r, pos, w_uk, w_uv)
    else:
        a = mla_sample(q_nope, q_rope, jnp.concatenate([past_c, c_kv], axis=1),
                       jnp.concatenate([past_kr, k_r], axis=1), w_uk, w_uv)
    a = a.reshape(B, T, MLA_HEADS * V_HEAD) @ w_mla_out
    r_q = rope(r_q.reshape(B, T, RET_HEADS, RET_DK), pos)
    r_k = rope(r_k.reshape(B, T, RET_HEADS, RET_DK), pos) * RET_K_SCALE
    r_v = r_v.reshape(B, T, RET_HEADS, RET_DV)
    if ret_s0 is None:
        ret_s0 = jnp.zeros((B, RET_HEADS, RET_DK, RET_DV), jnp.float32)
    r, s_new = retention(r_q, r_k, r_v, ret_s0)
    r = head_group_norm(r).reshape(B, T, RET_V_W).astype(x.dtype)
    r = (jax.nn.silu(r_g) * r) @ w_ret_out
    x = x + (jax.nn.sigmoid(g_mla) * a + jax.nn.sigmoid(g_ret) * r) @ w_out
    x = x + 0.5 * swiglu(rms_norm(x, ffn2_norm), ffn2_w13, ffn2_w2)
    return x, c_kv, k_r, s_new.astype(x.dtype)


def setup_inputs(seed: int = 0) -> dict:
    key = jax.random.key(seed)
    ks = jax.random.split(key, 24)
    f32 = jnp.float32

    def w(k, shape, fan_in):
        return jax.random.normal(k, shape, f32) * (fan_in ** -0.5)

    def gain(k, shape):
        return 1.0 + 0.01 * jax.random.normal(k, shape, f32)

    return {
        "x_prompt": jax.random.normal(ks[0], (BATCH, SEQ, D_MODEL), f32),
        "x_sample": jax.random.normal(ks[1], (DEC_BATCH, DEC_SEQ, D_MODEL), f32),
        "cache_ckv": jax.random.normal(ks[2], (DEPTH, DEC_BATCH, PAST_LEN, KV_LORA), f32),
        "cache_krope": jax.random.normal(ks[3], (DEPTH, DEC_BATCH, PAST_LEN, QK_ROPE), f32),
        "state_ret": jax.random.normal(ks[4], (DEPTH, DEC_BATCH, RET_HEADS, RET_DK, RET_DV), f32),
        "ffn1_norm": gain(ks[5], (DEPTH, D_MODEL)),
        "ffn1_w13": w(ks[6], (DEPTH, D_MODEL, 2 * D_FF), D_MODEL),
        "ffn1_w2": w(ks[7], (DEPTH, D_FF, D_MODEL), D_FF),
        "mix_norm": gain(ks[8], (DEPTH, D_MODEL)),
        "w_in": w(ks[9], (DEPTH, D_MODEL, IN_WIDTH), D_MODEL),
        "q_norm": gain(ks[10], (DEPTH, Q_LORA)),
        "kv_norm": gain(ks[11], (DEPTH, KV_LORA)),
        "w_uq": w(ks[12], (DEPTH, Q_LORA, MLA_HEADS * MLA_QK), Q_LORA),
        "w_uk": w(ks[13], (DEPTH, KV_LORA, MLA_HEADS, QK_NOPE), KV_LORA),
        "w_uv": w(ks[14], (DEPTH, KV_LORA, MLA_HEADS, V_HEAD), KV_LORA),
        "w_mla_out": w(ks[15], (DEPTH, MLA_HEADS * V_HEAD, D_MODEL), MLA_HEADS * V_HEAD),
        "w_ret_out": w(ks[16], (DEPTH, RET_V_W, D_MODEL), RET_V_W),
        "w_out": w(ks[17], (DEPTH, D_MODEL, D_MODEL), D_MODEL),
        "ffn2_norm": gain(ks[18], (DEPTH, D_MODEL)),
        "ffn2_w13": w(ks[19], (DEPTH, D_MODEL, 2 * D_FF), D_MODEL),
        "ffn2_w2": w(ks[20], (DEPTH, D_FF, D_MODEL), D_FF),
        "final_norm": gain(ks[21], (D_MODEL,)),
    }


def reference(x_prompt, x_sample, cache_ckv, cache_krope, state_ret, ffn1_norm, ffn1_w13, ffn1_w2,
              mix_norm, w_in, q_norm, kv_norm, w_uq, w_uk, w_uv, w_mla_out, w_ret_out, w_out,
              ffn2_norm, ffn2_w13, ffn2_w2, final_norm):
    past = cache_ckv.shape[2]
    pos_p = jnp.arange(x_prompt.shape[1])
    pos_s = past + jnp.arange(x_sample.shape[1])
    hp, hs = x_prompt, x_sample
    ckv_p, kr_p, ret_p, ckv_s, kr_s, ret_s = [], [], [], [], [], []
    for l in range(DEPTH):
        lw = (ffn1_norm[l], ffn1_w13[l], ffn1_w2[l], mix_norm[l], w_in[l], q_norm[l], kv_norm[l],
              w_uq[l], w_uk[l], w_uv[l], w_mla_out[l], w_ret_out[l], w_out[l],
              ffn2_norm[l], ffn2_w13[l], ffn2_w2[l])
        hp, c1, k1, s1 = trunk_layer(hp, pos_p, None, None, None, *lw)
        hs, c2, k2, s2 = trunk_layer(hs, pos_s, cache_ckv[l], cache_krope[l], state_ret[l], *lw)
        ckv_p.append(c1); kr_p.append(k1); ret_p.append(s1)
        ckv_s.append(c2); kr_s.append(k2); ret_s.append(s2)
    y_prompt = rms_norm(hp, final_norm)
    y_sample = rms_norm(hs, final_norm)
    return (y_prompt, y_sample, jnp.stack(ckv_p), jnp.stack(kr_p), jnp.stack(ret_p),
            jnp.stack(ckv_s), jnp.stack(kr_s), jnp.stack(ret_s))
```

```cpp
#include <hip/hip_runtime.h>
#include <cstdio>
#include <cstdint>

constexpr int D_MODEL = 2048, BATCH = 4, SEQ = 4096, DEPTH = 2, DEC_BATCH = 16, DEC_SEQ = 16, PAST_LEN = 2048;
constexpr int D_FF = 5632, IN_WIDTH = 11328;
constexpr float NORM_EPS = 1e-6f, GN_EPS = 1e-5f;
constexpr int MP = BATCH * SEQ;
constexpr int MS = DEC_BATCH * DEC_SEQ;
constexpr int MT = MP + MS;
constexpr float QSCALE = 0.07216878364870322f * 1.4426950408889634f;
constexpr float RET_K_SCALE = 0.08838834764831845f;
constexpr int CO_QL = 0, CO_C = 512, CO_KR = 1024, CO_RQ = 1088, CO_RK = 2112, CO_RV = 3136, CO_RG = 5184, CO_GM = 7232, CO_GR = 9280;
constexpr size_t OFF_Y = 0, OFF_CKVP = (size_t)MT * D_MODEL, OFF_KRP = OFF_CKVP + (size_t)DEPTH * MP * 512, OFF_RETP = OFF_KRP + (size_t)DEPTH * MP * 64,
                 OFF_CKVS = OFF_RETP + (size_t)DEPTH * BATCH * 8 * 128 * 256, OFF_KRS = OFF_CKVS + (size_t)DEPTH * MS * 512, OFF_RETS = OFF_KRS + (size_t)DEPTH * MS * 64,
                 OUT_TOTAL = OFF_RETS + (size_t)DEPTH * DEC_BATCH * 8 * 128 * 256;
static_assert(OUT_TOTAL == 63733760, "output size");

typedef unsigned short bf16;
__host__ __device__ __forceinline__ float bf2f(bf16 b) { union { unsigned u; float f; } x; x.u = ((unsigned)b) << 16; return x.f; }
__host__ __device__ __forceinline__ bf16 f2bf(float f) { union { unsigned u; float f; } x; x.f = f; unsigned u = x.u; u += 0x7fffu + ((u >> 16) & 1u); return (bf16)(u >> 16); }
__device__ __forceinline__ int row_pos(int r) { return r < MP ? (r % SEQ) : (PAST_LEN + ((r - MP) % DEC_SEQ)); }
__device__ __forceinline__ int fresh_lane() { int z = 0; asm volatile("" : "+v"(z)); return __builtin_amdgcn_mbcnt_hi(~0u, __builtin_amdgcn_mbcnt_lo(~0u, z)); }
__device__ __forceinline__ float silu_f(float v) { return v / (1.f + __expf(-v)); }
__device__ __forceinline__ float sigmoid_f(float v) { return 1.f / (1.f + __expf(-v)); }

constexpr size_t al256(size_t x) { return (x + 255) & ~(size_t)255; }
constexpr size_t WS_CTL = 0;
constexpr size_t WS_ROPE64 = 1u << 20;
constexpr size_t WS_ROPE128 = WS_ROPE64 + (size_t)4096 * 32 * 8;
constexpr size_t WS_SS = al256(WS_ROPE128 + (size_t)4096 * 64 * 8);
constexpr size_t WS_SQ = WS_SS + (size_t)MT * 32 * 4;
constexpr size_t WS_SC = WS_SQ + (size_t)MT * 8 * 4;
constexpr size_t WS_XB = al256(WS_SC + (size_t)MT * 8 * 4);
constexpr size_t WS_Q = WS_XB + (size_t)MT * 2048 * 2;
constexpr size_t WS_KN = WS_Q + (size_t)MT * 1536 * 2;
constexpr size_t WS_VV = WS_KN + (size_t)MP * 1024 * 2;
constexpr size_t WS_AR = WS_VV + (size_t)MP * 1024 * 2;
constexpr size_t WS_PROJ = WS_AR + (size_t)MT * 3072 * 2;
constexpr size_t WS_HB = WS_PROJ;
constexpr size_t WS_QL = WS_PROJ;
constexpr size_t WS_CRB = WS_QL + (size_t)MT * 512 * 2;
constexpr size_t WS_KR = WS_CRB + (size_t)MT * 512 * 2;
constexpr size_t WS_RQ = WS_KR + (size_t)MT * 64 * 2;
constexpr size_t WS_RK = WS_RQ + (size_t)MT * 1024 * 2;
constexpr size_t WS_RV = WS_RK + (size_t)MT * 1024 * 2;
constexpr size_t WS_RG = WS_RV + (size_t)MT * 2048 * 2;
constexpr size_t WS_GM = WS_RG + (size_t)MT * 2048 * 2;
constexpr size_t WS_GR = WS_GM + (size_t)MT * 2048 * 2;
constexpr size_t WS_PROJ_END = WS_GR + (size_t)MT * 2048 * 2;
static_assert(WS_HB + (size_t)MT * 5632 * 2 <= WS_PROJ_END, "HB overlay fits");
static_assert(WS_RK == WS_RQ + (size_t)MT * 1024 * 2 && WS_RG == WS_RV + (size_t)MT * 2048 * 2 && WS_GM == WS_RG + (size_t)MT * 2048 * 2 && WS_GR == WS_GM + (size_t)MT * 2048 * 2 && WS_VV == WS_KN + (size_t)MP * 1024 * 2 && WS_SC == WS_SQ + (size_t)MT * 8 * 4, "epilogues index these buffers as arrays");
constexpr size_t WS_WT = al256(WS_PROJ_END);
constexpr size_t WT_BYTES_TOTAL = 210239488;
constexpr size_t WS_CALL = al256(WS_WT + WT_BYTES_TOTAL);
constexpr size_t WS_SLAB = al256(WS_CALL + (size_t)DEC_BATCH * 2112 * 576 * 2);
constexpr size_t WS_END = WS_SLAB + (size_t)12 * MS * 2048 * 4;

namespace pg8 {
#define PG8_LAS __attribute__((address_space(3)))
typedef unsigned short bf16_t;
typedef short bf16x8 __attribute__((ext_vector_type(8)));
typedef float f32x4 __attribute__((ext_vector_type(4)));
typedef unsigned u32x4 __attribute__((ext_vector_type(4)));
constexpr int BM = 256, BK = 64, HALF = 128, HTB = HALF * BK * 2  , STAGE_BYTES = 8 * HTB, NXCD = 8, WGM = 4;

__host__ __device__ __forceinline__ int lds_byte(int r, int c) { const int st = (r >> 4) * 2 + (c >> 5), rr = r & 15, cc = c & 31, ob = rr * 64 + cc * 2; return st * 1024 + (ob ^ (((ob >> 9) & 1) << 5)); }
__host__ __device__ __forceinline__ void stage_rc(int b, int& R, int& C) { const int st = b / 1024, sb = b % 1024, swz = sb ^ (((sb >> 9) & 1) << 5); R = (st >> 1) * 16 + swz / 64; C = (st & 1) * 32 + (swz % 64) / 2; }
__host__ __device__ __forceinline__ int perm32(int rho) { const int n = rho >> 4, i = rho & 15; return 8 * (i >> 2) + 4 * n + (i & 3); }

struct Unit { int pm, pn, ko; };
struct Gemm { const bf16_t* A; const bf16_t* Bt; int M, N, K, lda, ldb; int kstepA = 0; size_t tstepA = 0; int kstepB = 0; size_t tstepB = 0; };

struct StaticOrder {
    int nM, nN, nwg, G, c;
    __host__ __device__ void init(int M, int N, int G_, int c_) { nM = M / BM; nN = N / BM; nwg = nM * nN; G = G_; c = c_; }
    __host__ __device__ bool next(int i, Unit& u) const {
        const long L = (long)i * G + c; if (L >= nwg) return false;
        int wgid = (int)L; { const int q = nwg / NXCD, r = nwg % NXCD, xcd = wgid % NXCD, off = wgid / NXCD; wgid = (xcd < r ? xcd * (q + 1) : r * (q + 1) + (xcd - r) * q) + off; }
        const int nig = WGM * nN, gid = wgid / nig, fm = gid * WGM, gsz = (nM - fm) < WGM ? (nM - fm) : WGM;
        u.pm = fm + ((wgid % nig) % gsz); u.pn = (wgid % nig) / gsz; u.ko = 0; return true;
    }
    __device__ __forceinline__ void a_ready(const Unit&) const {}
    __device__ __forceinline__ void done(const Unit&) const {}
};

struct SplitOrder {
    int nN, nS, ksl, G, c;
    __host__ __device__ void init(int N, int nslices, int ksl_, int G_, int c_) { nN = N / BM; nS = nslices; ksl = ksl_; G = G_; c = c_; }
    __device__ __forceinline__ bool next(int i, Unit& u) const { const int L = i * G + c; if (L >= nN * nS) return false; u.pm = 0; u.pn = L % nN; u.ko = (L / nN) * ksl; return true; }
    __device__ __forceinline__ void a_ready(const Unit&) const {}
    __device__ __forceinline__ void done(const Unit&) const {}
};

__device__ __forceinline__ unsigned cvt_pk_bf16(float lo, float hi) { unsigned r; asm volatile("v_cvt_pk_bf16_f32 %0, %1, %2" : "=v"(r) : "v"(lo), "v"(hi)); return r; }
typedef float f32x2 __attribute__((ext_vector_type(2)));
typedef unsigned u32x2 __attribute__((ext_vector_type(2)));
__device__ __forceinline__ u32x4 pack8(const f32x4& a, const f32x4& b) { u32x4 w; w.x = cvt_pk_bf16(a[0], a[1]); w.y = cvt_pk_bf16(a[2], a[3]); w.z = cvt_pk_bf16(b[0], b[1]); w.w = cvt_pk_bf16(b[2], b[3]); return w; }
__device__ __forceinline__ u32x2 pack4(const f32x4& a) { u32x2 w; w.x = cvt_pk_bf16(a[0], a[1]); w.y = cvt_pk_bf16(a[2], a[3]); return w; }
__device__ __forceinline__ void unpack8(const u32x4& w, f32x4& a, f32x4& b) {
    a[0] = __uint_as_float(w.x << 16); a[1] = __uint_as_float(w.x & 0xffff0000u); a[2] = __uint_as_float(w.y << 16); a[3] = __uint_as_float(w.y & 0xffff0000u);
    b[0] = __uint_as_float(w.z << 16); b[1] = __uint_as_float(w.z & 0xffff0000u); b[2] = __uint_as_float(w.w << 16); b[3] = __uint_as_float(w.w & 0xffff0000u); }
__device__ __forceinline__ float fsilu(float v) { return v * __builtin_amdgcn_rcpf(1.f + __expf(-v)); }
__device__ __forceinline__ float fsigm(float v) { return __builtin_amdgcn_rcpf(1.f + __expf(-v)); }
__device__ __forceinline__ float dot4(const f32x4& a) { return (a[0] * a[0] + a[1] * a[1]) + (a[2] * a[2] + a[3] * a[3]); }
template <int NS> __device__ __forceinline__ void load_rstd(const float* S, int rowbase, int fq, float invn, float (&rs)[2][4]) {
#pragma unroll
    for (int ai = 0; ai < 2; ++ai)
#pragma unroll
        for (int m = 0; m < 4; ++m) {
            const float* p = S + (size_t)(rowbase + ai * HALF + m * 16) * NS + fq * (NS / 4); float s;
            if constexpr (NS == 32) { const f32x4 a = *(const f32x4*)p, b = *(const f32x4*)(p + 4); s = ((a[0] + a[1]) + (a[2] + a[3])) + ((b[0] + b[1]) + (b[2] + b[3])); }
            else { const f32x2 a = *(const f32x2*)p; s = a[0] + a[1]; }
            s += __shfl_xor(s, 16); s += __shfl_xor(s, 32);
            rs[ai][m] = rsqrtf(s * invn + NORM_EPS);
        }
}
#define PG8_LAS_F __attribute__((address_space(3)))
template <int NS> __device__ __forceinline__ void fill_rstd_panel(const float* S, int pm, float invn, PG8_LAS_F float* rsl, int tid) {
    const int row = tid >> 1, hf = tid & 1; const float* p = S + ((size_t)pm * BM + row) * NS + hf * (NS / 2); float s;
    if constexpr (NS == 32) { const f32x4 a = *(const f32x4*)p, b = *(const f32x4*)(p + 4), c = *(const f32x4*)(p + 8), d = *(const f32x4*)(p + 12);
        s = (((a[0] + a[1]) + (a[2] + a[3])) + ((b[0] + b[1]) + (b[2] + b[3]))) + (((c[0] + c[1]) + (c[2] + c[3])) + ((d[0] + d[1]) + (d[2] + d[3]))); }
    else { const f32x4 a = *(const f32x4*)p; s = (a[0] + a[1]) + (a[2] + a[3]); }
    s += __shfl_xor(s, 1);
    if (hf == 0) rsl[row] = rsqrtf(s * invn + NORM_EPS);
}
__device__ __forceinline__ void read_rstd(const PG8_LAS_F float* rsl, int wr, int fr, float (&rs)[2][4]) {
#pragma unroll
    for (int ai = 0; ai < 2; ++ai)
#pragma unroll
        for (int m = 0; m < 4; ++m) rs[ai][m] = rsl[wr * 64 + fr + ai * HALF + m * 16];
}
__device__ __forceinline__ void rope8(const f32x4* cs, const f32x4& x1lo, const f32x4& x1hi, const f32x4& x2lo, const f32x4& x2hi, f32x4& y1lo, f32x4& y1hi, f32x4& y2lo, f32x4& y2hi) {
    const f32x4 c0 = cs[0], c1 = cs[1], c2 = cs[2], c3 = cs[3];
    const f32x4 coslo = {c0[0], c0[2], c1[0], c1[2]}, sinlo = {c0[1], c0[3], c1[1], c1[3]}, coshi = {c2[0], c2[2], c3[0], c3[2]}, sinhi = {c2[1], c2[3], c3[1], c3[3]};
    y1lo = x1lo * coslo - x2lo * sinlo; y2lo = x2lo * coslo + x1lo * sinlo; y1hi = x1hi * coshi - x2hi * sinhi; y2hi = x2hi * coshi + x1hi * sinhi;
}

struct EpiUp {
    static constexpr bool PERM = false, AFTER_DRAIN = false; static constexpr int RS_NS = 32; static constexpr float RS_INVN = 1.f / 2048.f; __device__ __forceinline__ const float* rs_src() const { return (const float*)(ws + WS_SS); }

    unsigned char* ws;
    __device__ __forceinline__ void operator()(const f32x4 (&acc)[2][2][4][2], const Unit& u, int wr, int wc, int fr, int fq, const PG8_LAS_F float* rsl) const {
        bf16_t* HB = (bf16_t*)(ws + WS_HB);
        const int rowbase = u.pm * BM + wr * 64 + fr; float rs[2][4]; read_rstd(rsl, wr, fr, rs);
        const int col = u.pn * 128 + wc * 32 + fq * 8;
#pragma unroll
        for (int ai = 0; ai < 2; ++ai)
#pragma unroll
            for (int m = 0; m < 4; ++m) { const float r = rs[ai][m], rl = r * -1.44269504f, r2 = r * r; f32x4 hh[2];
#pragma unroll
                for (int n = 0; n < 2; ++n) { const f32x4 a = acc[ai][0][m][n], t = a * rl; f32x4 d;
#pragma unroll
                    for (int e = 0; e < 4; ++e) d[e] = __builtin_amdgcn_exp2f(t[e]);
                    d = d + 1.f;
#pragma unroll
                    for (int e = 0; e < 4; ++e) d[e] = __builtin_amdgcn_rcpf(d[e]);
                    hh[n] = ((a * acc[ai][1][m][n]) * d) * r2; }
                const f32x4 h0 = hh[0], h1 = hh[1];
                *(u32x4*)(HB + ((size_t)(u.pm * (D_FF / 64) + (col >> 6)) * BM + (wr * 64 + fr + ai * HALF + m * 16)) * 64 + (col & 63)) = pack8(h0, h1); }
    }
};
struct EpiRes {
    static constexpr bool PERM = false, AFTER_DRAIN = false; static constexpr int RS_NS = 0;
    unsigned char* ws; float scale;
    __device__ __forceinline__ void operator()(const f32x4 (&acc)[2][2][4][2], const Unit& u, int wr, int wc, int fr, int fq) const {
        bf16_t* XB = (bf16_t*)(ws + WS_XB); float* SS = (float*)(ws + WS_SS);
        const int rowbase = u.pm * BM + wr * 64 + fr;
        u32x4 xr[2][4][2];
#pragma unroll
        for (int ai = 0; ai < 2; ++ai)
#pragma unroll
            for (int m = 0; m < 4; ++m)
#pragma unroll
                for (int bj = 0; bj < 2; ++bj) xr[ai][m][bj] = *(const u32x4*)(XB + (size_t)(rowbase + ai * HALF + m * 16) * 2048 + u.pn * BM + bj * HALF + wc * 32 + fq * 8);
#pragma unroll
        for (int ai = 0; ai < 2; ++ai)
#pragma unroll
            for (int m = 0; m < 4; ++m) { const int row = rowbase + ai * HALF + m * 16; float ssq = 0.f;
#pragma unroll
                for (int bj = 0; bj < 2; ++bj) { const size_t idx = (size_t)row * 2048 + u.pn * BM + bj * HALF + wc * 32 + fq * 8;
                    f32x4 x0, x1; unpack8(xr[ai][m][bj], x0, x1); x0 += acc[ai][bj][m][0] * scale; x1 += acc[ai][bj][m][1] * scale;
                    *(u32x4*)(XB + idx) = pack8(x0, x1); ssq += dot4(x0) + dot4(x1); }
                ssq += __shfl_xor(ssq, 16); ssq += __shfl_xor(ssq, 32);
                if (fq == 0) SS[(size_t)row * 32 + u.pn * 4 + wc] = ssq; }
    }
};
struct EpiWin {
    static constexpr bool PERM = false, AFTER_DRAIN = false; static constexpr int RS_NS = 32; static constexpr float RS_INVN = 1.f / 2048.f; __device__ __forceinline__ const float* rs_src() const { return (const float*)(ws + WS_SS); }

    unsigned char* ws; float* out; int layer;
    __device__ __forceinline__ void operator()(const f32x4 (&acc)[2][2][4][2], const Unit& u, int wr, int wc, int fr, int fq, const PG8_LAS_F float* rsl) const {
        bf16_t *QL = (bf16_t*)(ws + WS_QL), *CRB = (bf16_t*)(ws + WS_CRB), *KR = (bf16_t*)(ws + WS_KR);
        const float2 *t64 = (const float2*)(ws + WS_ROPE64), *t128 = (const float2*)(ws + WS_ROPE128);
        const int rowbase = u.pm * BM + wr * 64 + fr; float rs[2][4]; read_rstd(rsl, wr, fr, rs);
        const int t = u.pn;
        if (t < 4) {
#pragma unroll
            for (int ai = 0; ai < 2; ++ai)
#pragma unroll
                for (int m = 0; m < 4; ++m) { const int row = rowbase + ai * HALF + m * 16; const float r = rs[ai][m]; float ssq = 0.f;
#pragma unroll
                    for (int bj = 0; bj < 2; ++bj) { const f32x4 v0 = acc[ai][bj][m][0] * r, v1 = acc[ai][bj][m][1] * r; const size_t idx = (size_t)row * 512 + (t & 1) * 256 + bj * HALF + wc * 32 + fq * 8;
                        if (t < 2) *(u32x4*)(QL + idx) = pack8(v0, v1);
                        else *(u32x4*)(CRB + idx) = pack8(v0, v1);
                        ssq += dot4(v0) + dot4(v1); }
                    ssq += __shfl_xor(ssq, 16); ssq += __shfl_xor(ssq, 32);
                    if (fq == 0) ((float*)(ws + WS_SQ) + (t >> 1) * (size_t)MT * 8)[(size_t)row * 8 + (t & 1) * 4 + wc] = ssq; }
        } else if (t < 12) {
            bf16_t* dst = (bf16_t*)(ws + WS_RQ) + (t >> 3) * (size_t)MT * 1024; const float ks = t < 8 ? 1.f : RET_K_SCALE; const int head = 2 * ((t - 4) & 3) + (wc >> 1), idx0 = 32 * (wc & 1) + 8 * fq;
#pragma unroll
            for (int ai = 0; ai < 2; ++ai) { f32x4 csv[2][4];
#pragma unroll
                for (int mh = 0; mh < 2; ++mh) {
#pragma unroll
                for (int mm = 0; mm < 2; ++mm) { const f32x4* cp = (const f32x4*)(t128 + (size_t)row_pos(rowbase + ai * HALF + (2 * mh + mm) * 16) * 64 + idx0); csv[mm][0] = cp[0]; csv[mm][1] = cp[1]; csv[mm][2] = cp[2]; csv[mm][3] = cp[3]; }
#pragma unroll
                for (int mm = 0; mm < 2; ++mm) { const int m = 2 * mh + mm; const int row = rowbase + ai * HALF + m * 16; const float r = rs[ai][m] * ks; const f32x4* cs = csv[mm];
                    f32x4 y1lo, y1hi, y2lo, y2hi; rope8(cs, acc[ai][0][m][0] * r, acc[ai][1][m][0] * r, acc[ai][0][m][1] * r, acc[ai][1][m][1] * r, y1lo, y1hi, y2lo, y2hi);
                    bf16_t* d = dst + (size_t)row * 1024 + head * 128 + idx0; *(u32x4*)d = pack8(y1lo, y1hi); *(u32x4*)(d + 64) = pack8(y2lo, y2hi); } } }
        } else if (t < 44) {
            const int kind = (t - 12) >> 3, tt = (t - 12) & 7; bf16_t* dst = (bf16_t*)(ws + WS_RV) + kind * (size_t)MT * 2048;
#pragma unroll
            for (int ai = 0; ai < 2; ++ai)
#pragma unroll
                for (int m = 0; m < 4; ++m) { const int row = rowbase + ai * HALF + m * 16; const float r = rs[ai][m];
#pragma unroll
                    for (int bj = 0; bj < 2; ++bj) { f32x4 v0 = acc[ai][bj][m][0] * r, v1 = acc[ai][bj][m][1] * r;
                        if (kind == 1) {
#pragma unroll
                            for (int e = 0; e < 4; ++e) { v0[e] = fsilu(v0[e]); v1[e] = fsilu(v1[e]); } }
                        else if (kind >= 2) {
#pragma unroll
                            for (int e = 0; e < 4; ++e) { v0[e] = fsigm(v0[e]); v1[e] = fsigm(v1[e]); } }
                        *(u32x4*)(dst + (size_t)row * 2048 + tt * 256 + bj * HALF + wc * 32 + fq * 8) = pack8(v0, v1); } }
        } else {
            if (wc < 2) { const int idx0 = 16 * wc + 4 * fq;
#pragma unroll
                for (int ai = 0; ai < 2; ++ai) { f32x4 ct[4][2];
#pragma unroll
                    for (int m = 0; m < 4; ++m) { const f32x4* cs = (const f32x4*)(t64 + (size_t)row_pos(rowbase + ai * HALF + m * 16) * 32 + idx0); ct[m][0] = cs[0]; ct[m][1] = cs[1]; }
#pragma unroll
                    for (int m = 0; m < 4; ++m) { const int row = rowbase + ai * HALF + m * 16; const float r = rs[ai][m];
                        const f32x4 c0 = ct[m][0], c1 = ct[m][1], co = {c0[0], c0[2], c1[0], c1[2]}, si = {c0[1], c0[3], c1[1], c1[3]}, x1 = acc[ai][0][m][0] * r, x2 = acc[ai][0][m][1] * r;
                        const f32x4 y1 = x1 * co - x2 * si, y2 = x2 * co + x1 * si;
                        float* ko = row < MP ? out + OFF_KRP + ((size_t)layer * MP + row) * 64 : out + OFF_KRS + ((size_t)layer * MS + (row - MP)) * 64;
                        *(f32x4*)(ko + idx0) = y1; *(f32x4*)(ko + 32 + idx0) = y2; *(u32x2*)(KR + (size_t)row * 64 + idx0) = pack4(y1); *(u32x2*)(KR + (size_t)row * 64 + 32 + idx0) = pack4(y2); } } }
        }
    }
};
struct EpiQ {
    static constexpr bool PERM = false, AFTER_DRAIN = false; static constexpr int RS_NS = 8; static constexpr float RS_INVN = 1.f / 512.f; __device__ __forceinline__ const float* rs_src() const { return (const float*)(ws + WS_SQ); }

    unsigned char* ws;
    __device__ __forceinline__ void operator()(const f32x4 (&acc)[2][2][4][2], const Unit& u, int wr, int wc, int fr, int fq, const PG8_LAS_F float* rsl) const {
        bf16_t* Q = (bf16_t*)(ws + WS_Q); const float2* t64 = (const float2*)(ws + WS_ROPE64);
        const int rowbase = u.pm * BM + wr * 64 + fr; float rs[2][4]; read_rstd(rsl, wr, fr, rs);
        const int t = u.pn;
        if (t < 4) {
#pragma unroll
            for (int ai = 0; ai < 2; ++ai)
#pragma unroll
                for (int m = 0; m < 4; ++m) { const int row = rowbase + ai * HALF + m * 16; const float r = rs[ai][m] * QSCALE;
#pragma unroll
                    for (int bj = 0; bj < 2; ++bj) *(u32x4*)(Q + (size_t)row * 1536 + (2 * t + bj) * 192 + wc * 32 + fq * 8) = pack8(acc[ai][bj][m][0] * r, acc[ai][bj][m][1] * r); }
        } else { const int head = 4 * (t - 4) + wc, idx0 = 8 * fq;
#pragma unroll
            for (int ai = 0; ai < 2; ++ai) { f32x4 csv[2][4];
#pragma unroll
                for (int mh = 0; mh < 2; ++mh) {
#pragma unroll
                for (int mm = 0; mm < 2; ++mm) { const f32x4* cp = (const f32x4*)(t64 + (size_t)row_pos(rowbase + ai * HALF + (2 * mh + mm) * 16) * 32 + idx0); csv[mm][0] = cp[0]; csv[mm][1] = cp[1]; csv[mm][2] = cp[2]; csv[mm][3] = cp[3]; }
#pragma unroll
                for (int mm = 0; mm < 2; ++mm) { const int m = 2 * mh + mm; const int row = rowbase + ai * HALF + m * 16; const float r = rs[ai][m] * QSCALE; const f32x4* cs = csv[mm];
                    f32x4 y1lo, y1hi, y2lo, y2hi; rope8(cs, acc[ai][0][m][0] * r, acc[ai][1][m][0] * r, acc[ai][0][m][1] * r, acc[ai][1][m][1] * r, y1lo, y1hi, y2lo, y2hi);
                    bf16_t* d = Q + (size_t)row * 1536 + head * 192 + 128 + idx0; *(u32x4*)d = pack8(y1lo, y1hi); *(u32x4*)(d + 32) = pack8(y2lo, y2hi); } } }
        }
    }
};
struct EpiKV {
    static constexpr bool PERM = false, AFTER_DRAIN = false; static constexpr int RS_NS = 8; static constexpr float RS_INVN = 1.f / 512.f; __device__ __forceinline__ const float* rs_src() const { return (const float*)(ws + WS_SC); }

    unsigned char* ws;
    __device__ __forceinline__ void operator()(const f32x4 (&acc)[2][2][4][2], const Unit& u, int wr, int wc, int fr, int fq, const PG8_LAS_F float* rsl) const {
        const int rowbase = u.pm * BM + wr * 64 + fr; float rs[2][4]; read_rstd(rsl, wr, fr, rs);
        bf16_t* dst = (bf16_t*)(ws + WS_KN) + (u.pn >> 2) * (size_t)MP * 1024 + (u.pn & 3) * 256 + wc * 32 + fq * 8;
#pragma unroll
        for (int ai = 0; ai < 2; ++ai)
#pragma unroll
            for (int m = 0; m < 4; ++m) { const int row = rowbase + ai * HALF + m * 16; const float r = rs[ai][m];
#pragma unroll
                for (int bj = 0; bj < 2; ++bj) *(u32x4*)(dst + (size_t)row * 1024 + bj * HALF) = pack8(acc[ai][bj][m][0] * r, acc[ai][bj][m][1] * r); }
    }
};
template <int MODE> struct EpiGate {
    static constexpr bool PERM = false, AFTER_DRAIN = false; static constexpr int RS_NS = 0;
    unsigned char* ws;
    __device__ __forceinline__ void operator()(const f32x4 (&acc)[2][2][4][2], const Unit& u, int wr, int wc, int fr, int fq) const {
        bf16_t* GM = (bf16_t*)(ws + WS_GM); const bf16_t* GR = (const bf16_t*)(ws + WS_GR);
        const int rowbase = u.pm * BM + wr * 64 + fr;
#pragma unroll
        for (int ai = 0; ai < 2; ++ai) { u32x4 gm[4][2], gr[4][2];
#pragma unroll
            for (int m = 0; m < 4; ++m)
#pragma unroll
                for (int bj = 0; bj < 2; ++bj) { const size_t idx = (size_t)(rowbase + ai * HALF + m * 16) * 2048 + u.pn * BM + bj * HALF + wc * 32 + fq * 8; gm[m][bj] = *(const u32x4*)(GM + idx); if (MODE == 1) gr[m][bj] = *(const u32x4*)(GR + idx); }
#pragma unroll
            for (int m = 0; m < 4; ++m)
#pragma unroll
                for (int bj = 0; bj < 2; ++bj) { const size_t idx = (size_t)(rowbase + ai * HALF + m * 16) * 2048 + u.pn * BM + bj * HALF + wc * 32 + fq * 8; f32x4 g0, g1; unpack8(gm[m][bj], g0, g1);
                    if (MODE == 0) { g0 *= acc[ai][bj][m][0]; g1 *= acc[ai][bj][m][1]; }
                    else { f32x4 r0, r1; unpack8(gr[m][bj], r0, r1); g0 += r0 * acc[ai][bj][m][0]; g1 += r1 * acc[ai][bj][m][1]; }
                    *(u32x4*)(GM + idx) = pack8(g0, g1); } }
    }
};

struct EpiSlab {
    static constexpr bool PERM = false, AFTER_DRAIN = false; static constexpr int RS_NS = 0;
    float* slab; int slice0, ksl;
    __device__ __forceinline__ void operator()(const f32x4 (&acc)[2][2][4][2], const Unit& u, int wr, int wc, int fr, int fq) const {
        float* base = slab + ((size_t)(slice0 + u.ko / ksl) * BM + wr * 64 + fr) * 2048 + u.pn * BM + wc * 32 + fq * 8;
#pragma unroll
        for (int ai = 0; ai < 2; ++ai)
#pragma unroll
            for (int m = 0; m < 4; ++m)
#pragma unroll
                for (int bj = 0; bj < 2; ++bj) { float* p = base + (size_t)(ai * HALF + m * 16) * 2048 + bj * HALF; *(f32x4*)p = acc[ai][bj][m][0]; *(f32x4*)(p + 4) = acc[ai][bj][m][1]; }
    }
};

template <class Epi, class Sched, bool ALIGN_EPI = false, bool SP2 = false>
__device__ __forceinline__ void gemm_phase(PG8_LAS unsigned char* lds, const Gemm g_in, const Sched& S, const Epi& E, int wave_id) {
    Gemm g = g_in; { const bf16_t* pa = g.A; const bf16_t* pb = g.Bt; asm volatile("" : "+s"(pa), "+s"(pb)); g.A = pa; g.Bt = pb; }
    const int wid = wave_id, lane = fresh_lane(), tid = wid * 64 + lane,
              wr = wid >> 2, wc = wid & 3, fr = lane & 15, fq = lane >> 4;
    const int K = g.K, nt = K / BK;
    unsigned voffA[2], voffB[2];
#pragma unroll
    for (int i = 0; i < 2; ++i) { int R, C; stage_rc(tid * 16 + i * 8192, R, C); const int Rb = Epi::PERM ? ((R & ~31) + perm32(R & 31)) : R;
        voffA[i] = (unsigned)(R * g.lda + C) * 2u; voffB[i] = (unsigned)(Rb * g.ldb + C) * 2u; }
    const size_t kstepB = g.kstepB ? (size_t)g.kstepB : (size_t)(BK * 2), kstepA = g.kstepA ? (size_t)g.kstepA : (size_t)(BK * 2);
    const size_t hstepA = (size_t)HALF * g.lda * 2, hstepB = (size_t)HALF * g.ldb * 2;
    const size_t tstepA = g.tstepA ? g.tstepA : 2 * hstepA, tstepB = g.tstepB ? g.tstepB : 2 * hstepB;
    const unsigned ldsw = (unsigned)wid * 1024u;
    const int aoff = lds_byte(wr * 64 + fr, fq * 8), boff = lds_byte(wc * 32 + fr, fq * 8);
#define PG8_SA(b, h) (((b) * 2 + (h)) * HTB)
#define PG8_SB(b, h) ((4 + (b) * 2 + (h)) * HTB)
#define PG8_STAGE(bufoff, gbase, voff) do { _Pragma("unroll") for (int _i = 0; _i < 2; ++_i) \
        __builtin_amdgcn_global_load_lds((const unsigned*)((const char*)(gbase) + (voff)[_i]), (PG8_LAS unsigned*)(lds + (bufoff) + ldsw + _i * 8192), 16, 0, 0); } while (0)
#define PG8_LDA(dst, b, h) do { _Pragma("unroll") for (int m = 0; m < 4; ++m) _Pragma("unroll") for (int k = 0; k < 2; ++k) dst[m][k] = *(const PG8_LAS bf16x8*)(lds + PG8_SA(b, h) + aoff + m * 2048 + k * 1024); } while (0)
#define PG8_LDB(dst, b, h) do { _Pragma("unroll") for (int n = 0; n < 2; ++n) _Pragma("unroll") for (int k = 0; k < 2; ++k) dst[n][k] = *(const PG8_LAS bf16x8*)(lds + PG8_SB(b, h) + boff + n * 2048 + k * 1024); } while (0)
#define PG8_MMA(ai, bj, At, Bt) do { __builtin_amdgcn_s_setprio(1); _Pragma("unroll") for (int m = 0; m < 4; ++m) _Pragma("unroll") for (int n = 0; n < 2; ++n) _Pragma("unroll") for (int k = 0; k < 2; ++k) \
        acc[ai][bj][m][n] = __builtin_amdgcn_mfma_f32_16x16x32_bf16(Bt[n][k], At[m][k], acc[ai][bj][m][n], 0, 0, 0); __builtin_amdgcn_s_setprio(0); } while (0)
#define PG8_WAIT_V(n) asm volatile("s_waitcnt vmcnt(" #n ")" ::: "memory")
#define PG8_WAIT_L(n) asm volatile("s_waitcnt lgkmcnt(" #n ")" ::: "memory")
#define PG8_BAR __builtin_amdgcn_s_barrier()
#define PG8_SCHED __builtin_amdgcn_sched_barrier(0)
    Unit cur, nxt; int ui = 0, rs_pm = -1;
    if (!S.next(0, cur)) return;
    f32x4 acc[2][2][4][2];
#pragma unroll
    for (int a = 0; a < 2; ++a)
#pragma unroll
        for (int b = 0; b < 2; ++b)
#pragma unroll
            for (int m = 0; m < 4; ++m)
#pragma unroll
                for (int n = 0; n < 2; ++n) acc[a][b][m][n] = (f32x4){0.f, 0.f, 0.f, 0.f};
    bf16x8 At[4][2], B0[2][2], B1[2][2];
    const char* cA = (const char*)g.A + (size_t)cur.pm * tstepA + (size_t)(cur.ko / BK) * kstepA; const char* cB = (const char*)g.Bt + (size_t)cur.pn * tstepB + (size_t)(cur.ko / BK) * kstepB;
    S.a_ready(cur);
    if constexpr (SP2) {
        PG8_STAGE(PG8_SB(0, 0), cB, voffB); PG8_STAGE(PG8_SB(0, 1), cB + hstepB, voffB); PG8_STAGE(PG8_SA(0, 0), cA, voffA); PG8_STAGE(PG8_SA(0, 1), cA + hstepA, voffA);
        if (wr == 1) PG8_BAR;
        PG8_WAIT_V(2); PG8_BAR;
        PG8_STAGE(PG8_SB(1, 0), cB + kstepB, voffB); PG8_STAGE(PG8_SA(1, 0), cA + kstepA, voffA); PG8_STAGE(PG8_SB(1, 1), cB + hstepB + kstepB, voffB);
        PG8_WAIT_V(6); PG8_BAR;
    } else {
        PG8_STAGE(PG8_SB(0, 0), cB, voffB); PG8_STAGE(PG8_SA(0, 0), cA, voffA); PG8_STAGE(PG8_SB(0, 1), cB + hstepB, voffB); PG8_STAGE(PG8_SA(0, 1), cA + hstepA, voffA);
        if (wr == 1) PG8_BAR;
        PG8_WAIT_V(4); PG8_BAR;
        PG8_STAGE(PG8_SB(1, 0), cB + kstepB, voffB); PG8_STAGE(PG8_SA(1, 0), cA + kstepA, voffA); PG8_STAGE(PG8_SB(1, 1), cB + hstepB + kstepB, voffB);
        PG8_WAIT_V(6); PG8_BAR;
    }
    for (;;) {
        const bool has_next = S.next(ui + 1, nxt);
        const char* nA = has_next ? (const char*)g.A + (size_t)nxt.pm * tstepA + (size_t)(nxt.ko / BK) * kstepA : cA; const char* nB = has_next ? (const char*)g.Bt + (size_t)nxt.pn * tstepB + (size_t)(nxt.ko / BK) * kstepB : cB;
        for (int t = 0; t < nt; t += 2) {
            const bool last = (t == nt - 2);
            const char* a1 = cA + (size_t)(t + 1) * kstepA;
            const char* a2 = last ? nA : cA + (size_t)(t + 2) * kstepA; const char* b2 = last ? nB : cB + (size_t)(t + 2) * kstepB;
            const char* a3 = a2 + kstepA; const char* b3 = b2 + kstepB;
            if (last && has_next) S.a_ready(nxt);
            if constexpr (SP2) {
            PG8_LDB(B0, 0, 0); PG8_LDB(B1, 0, 1); PG8_SCHED; PG8_LDA(At, 0, 0); PG8_STAGE(PG8_SA(1, 1), a1 + hstepA, voffA);
            PG8_WAIT_V(8); PG8_WAIT_L(0); PG8_BAR; PG8_MMA(0, 0, At, B0); PG8_MMA(0, 1, At, B1); PG8_BAR; PG8_SCHED;
            PG8_LDA(At, 0, 1); PG8_STAGE(PG8_SB(0, 0), b2, voffB); PG8_STAGE(PG8_SB(0, 1), b2 + hstepB, voffB); PG8_STAGE(PG8_SA(0, 0), a2, voffA);
            PG8_WAIT_V(8); PG8_WAIT_L(0); PG8_BAR; PG8_MMA(1, 0, At, B0); PG8_MMA(1, 1, At, B1); PG8_BAR; PG8_SCHED;
            PG8_LDB(B0, 1, 0); PG8_LDB(B1, 1, 1); PG8_SCHED; PG8_LDA(At, 1, 0); PG8_STAGE(PG8_SA(0, 1), a2 + hstepA, voffA);
            PG8_WAIT_V(8); PG8_WAIT_L(0); PG8_BAR; PG8_MMA(0, 0, At, B0); PG8_MMA(0, 1, At, B1); PG8_BAR; PG8_SCHED;
            PG8_LDA(At, 1, 1); PG8_STAGE(PG8_SB(1, 0), b3, voffB); PG8_STAGE(PG8_SB(1, 1), b3 + hstepB, voffB); PG8_STAGE(PG8_SA(1, 0), a3, voffA);
            PG8_WAIT_V(8); PG8_WAIT_L(0); PG8_BAR; PG8_MMA(1, 0, At, B0); PG8_MMA(1, 1, At, B1); PG8_BAR; PG8_SCHED;
            } else {
            PG8_LDB(B0, 0, 0); PG8_SCHED; PG8_LDA(At, 0, 0); PG8_STAGE(PG8_SA(1, 1), a1 + hstepA, voffA);
            PG8_WAIT_L(8); PG8_BAR; PG8_WAIT_L(0); PG8_MMA(0, 0, At, B0); PG8_BAR; PG8_SCHED;
            PG8_LDB(B1, 0, 1); PG8_STAGE(PG8_SB(0, 0), b2, voffB);
            PG8_BAR; PG8_WAIT_L(0); PG8_MMA(0, 1, At, B1); PG8_BAR;
            PG8_LDA(At, 0, 1); PG8_STAGE(PG8_SA(0, 0), a2, voffA);
            PG8_BAR; PG8_WAIT_L(0); PG8_MMA(1, 0, At, B0); PG8_BAR; PG8_SCHED;
            PG8_STAGE(PG8_SB(0, 1), b2 + hstepB, voffB);
            PG8_WAIT_V(6); PG8_BAR; PG8_MMA(1, 1, At, B1); PG8_BAR;
            PG8_LDB(B0, 1, 0); PG8_SCHED; PG8_LDA(At, 1, 0); PG8_STAGE(PG8_SA(0, 1), a2 + hstepA, voffA);
            PG8_WAIT_L(8); PG8_BAR; PG8_WAIT_L(0); PG8_MMA(0, 0, At, B0); PG8_BAR; PG8_SCHED;
            PG8_LDB(B1, 1, 1); PG8_STAGE(PG8_SB(1, 0), b3, voffB);
            PG8_BAR; PG8_WAIT_L(0); PG8_MMA(0, 1, At, B1); PG8_BAR;
            PG8_LDA(At, 1, 1); PG8_STAGE(PG8_SA(1, 0), a3, voffA);
            PG8_BAR; PG8_WAIT_L(0); PG8_MMA(1, 0, At, B0); PG8_BAR; PG8_SCHED;
            PG8_STAGE(PG8_SB(1, 1), b3 + hstepB, voffB);
            PG8_WAIT_V(6); PG8_BAR; PG8_MMA(1, 1, At, B1); PG8_BAR;
            }
        }
        if constexpr (ALIGN_EPI) { if (wr == 0) PG8_BAR; }
        if constexpr (Epi::RS_NS > 0) {
            PG8_LAS_F float* rsl = (PG8_LAS_F float*)(lds + STAGE_BYTES + 1024);
            if (cur.pm != rs_pm) { rs_pm = cur.pm; fill_rstd_panel<Epi::RS_NS>(E.rs_src(), cur.pm, Epi::RS_INVN, rsl, tid); PG8_WAIT_L(0); PG8_BAR; }
            E(acc, cur, wr, wc, fr, fq, rsl); S.done(cur);
        } else
        if constexpr (!Epi::AFTER_DRAIN) { E(acc, cur, wr, wc, fr, fq); S.done(cur); }
        if (!has_next) break;
#pragma unroll
        for (int a = 0; a < 2; ++a)
#pragma unroll
            for (int b = 0; b < 2; ++b)
#pragma unroll
                for (int m = 0; m < 4; ++m)
#pragma unroll
                    for (int n = 0; n < 2; ++n) acc[a][b][m][n] = (f32x4){0.f, 0.f, 0.f, 0.f};
        cur = nxt; cA = nA; cB = nB; ++ui;
        if constexpr (ALIGN_EPI) { if (wr == 1) PG8_BAR; }
    }
    PG8_WAIT_V(0);
    if constexpr (!ALIGN_EPI) { if (wr == 0) PG8_BAR; }
    PG8_BAR;
    if constexpr (Epi::AFTER_DRAIN) { E.fused(acc, cur, wr, wc, fr, fq, lds, wid, lane); S.done(cur); }
#undef PG8_SA
#undef PG8_SB
#undef PG8_STAGE
#undef PG8_LDA
#undef PG8_LDB
#undef PG8_MMA
#undef PG8_WAIT_V
#undef PG8_WAIT_L
#undef PG8_BAR
#undef PG8_SCHED
}
}


namespace mix {
#define MLAS __attribute__((address_space(3)))
typedef short bf16x8 __attribute__((ext_vector_type(8)));
typedef short s16x4 __attribute__((ext_vector_type(4)));
typedef float f32x16 __attribute__((ext_vector_type(16)));
typedef float f32x4 __attribute__((ext_vector_type(4)));
typedef float f32x2_t __attribute__((ext_vector_type(2))); typedef __bf16 bf16x2_t __attribute__((ext_vector_type(2)));
typedef unsigned u32x4 __attribute__((ext_vector_type(4)));
typedef unsigned u32x2 __attribute__((ext_vector_type(2)));
typedef short v4i16_t __attribute__((ext_vector_type(4)));
#define MFMA32(a, b, c) __builtin_amdgcn_mfma_f32_32x32x16_bf16((a), (b), (c), 0, 0, 0)
__device__ __forceinline__ unsigned cvtpk(float lo, float hi) { f32x2_t v = {lo, hi}; bf16x2_t b = __builtin_convertvector(v, bf16x2_t); return __builtin_bit_cast(unsigned, b); }
__device__ __forceinline__ s16x4 tr_read(const MLAS char* p) { return __builtin_bit_cast(s16x4, __builtin_amdgcn_ds_read_tr16_b64_v4i16((MLAS v4i16_t*)p)); }
__device__ __forceinline__ bf16x8 cat8(s16x4 lo, s16x4 hi) { return __builtin_shufflevector(lo, hi, 0, 1, 2, 3, 4, 5, 6, 7); }
__device__ __forceinline__ int crow(int r, int hi) { return (r & 3) + 8 * (r >> 2) + 4 * hi; }
__device__ __forceinline__ bf16x8 pack_step(const f32x16& x, int s) { u32x4 p; p.x = cvtpk(x[8 * s], x[8 * s + 1]); p.y = cvtpk(x[8 * s + 2], x[8 * s + 3]); p.z = cvtpk(x[8 * s + 4], x[8 * s + 5]); p.w = cvtpk(x[8 * s + 6], x[8 * s + 7]); return __builtin_bit_cast(bf16x8, p); }

constexpr int ATT_KP = 400, ATT_VP = 288, ATT_VOFF = 64 * ATT_KP, ATT_LDS = ATT_VOFF + 64 * ATT_VP;
__device__ __forceinline__ void attn_unit(MLAS char* L, const unsigned char* ws, int b, int h, int qb, int w) {
    const int lane = fresh_lane(), tid = w * 64 + lane, r = lane & 31, hh = lane >> 5;
    const bf16* Q = (const bf16*)(ws + WS_Q); const bf16* KN = (const bf16*)(ws + WS_KN); const bf16* KR = (const bf16*)(ws + WS_KR); const bf16* VV = (const bf16*)(ws + WS_VV); bf16* AR = (bf16*)(ws + WS_AR);
    const int row = b * SEQ + qb * 256 + w * 32 + r;
    bf16x8 qf[12];
#pragma unroll
    for (int s = 0; s < 12; ++s) qf[s] = *(const bf16x8*)(Q + (size_t)row * 1536 + h * 192 + 16 * s + 8 * hh);
    const int my_last = 4 * qb + (w >> 1), ntiles = 4 * qb + 4;
    const char* knb = (const char*)(KN + (size_t)b * SEQ * 1024 + h * 128); const char* krb = (const char*)(KR + (size_t)b * SEQ * 64); const char* vvb = (const char*)(VV + (size_t)b * SEQ * 1024 + h * 128);
    const unsigned noff = ((tid >> 4) * 1024 + (tid & 15) * 8) * 2, roff = tid * 16;
    const int ndst = (tid >> 4) * ATT_KP + (tid & 15) * 16, rdst = (tid >> 3) * ATT_KP + 256 + (tid & 7) * 16, vdst0 = ATT_VOFF + (tid >> 4) * ATT_VP + (tid & 15) * 16;
    u32x4 kreg[3], vreg[2];
    kreg[0] = *(const u32x4*)(knb + noff); kreg[1] = *(const u32x4*)(knb + 65536 + noff); kreg[2] = *(const u32x4*)(krb + roff);
    vreg[0] = *(const u32x4*)(vvb + noff); vreg[1] = *(const u32x4*)(vvb + 65536 + noff);
    f32x16 O[4];
#pragma unroll
    for (int c = 0; c < 4; ++c)
#pragma unroll
        for (int i = 0; i < 16; ++i) O[c][i] = 0.f;
    float m = -1e30f, l = 0.f;
    const int i16 = lane & 15, tr_off = (4 * hh + (i16 >> 2)) * ATT_VP + 32 * ((lane >> 4) & 1) + 8 * (i16 & 3);
#define ATT_STAGE(LB) { *(MLAS u32x4*)((LB) + ndst) = kreg[0]; *(MLAS u32x4*)((LB) + ndst + 32 * ATT_KP) = kreg[1]; *(MLAS u32x4*)((LB) + rdst) = kreg[2]; *(MLAS u32x4*)((LB) + vdst0) = vreg[0]; *(MLAS u32x4*)((LB) + vdst0 + 32 * ATT_VP) = vreg[1]; }
#define ATT_FETCH() { knb += 64 * 1024 * 2; krb += 64 * 64 * 2; vvb += 64 * 1024 * 2; \
        kreg[0] = *(const u32x4*)(knb + noff); kreg[1] = *(const u32x4*)(knb + 65536 + noff); kreg[2] = *(const u32x4*)(krb + roff); vreg[0] = *(const u32x4*)(vvb + noff); vreg[1] = *(const u32x4*)(vvb + 65536 + noff); }
    MLAS char* const L0 = L;
    __syncthreads();
    ATT_STAGE(L0)
    if (ntiles > 1) ATT_FETCH()
    __syncthreads();
    for (int kt = 0; kt < ntiles; ++kt) {
        L = L0 + (kt & 1) * ATT_LDS;
        if (kt + 1 < ntiles) { MLAS char* const LN = L0 + ((kt + 1) & 1) * ATT_LDS; ATT_STAGE(LN) if (kt + 2 < ntiles) ATT_FETCH() }
        if (kt <= my_last) {
            f32x16 s0, s1;
#pragma unroll
            for (int i = 0; i < 16; ++i) { s0[i] = 0.f; s1[i] = 0.f; }
            const MLAS char* kp0 = L + r * ATT_KP + 16 * hh; const MLAS char* kp1 = kp0 + 32 * ATT_KP;
            bf16x8 ka[4], kb[4];
#define ATT_SB __builtin_amdgcn_sched_barrier(0);
#define ATT_KLOAD(buf, s2) _Pragma("unroll") for (int j = 0; j < 2; ++j) { buf[2 * j] = *(const MLAS bf16x8*)(kp0 + 32 * ((s2) + j)); buf[2 * j + 1] = *(const MLAS bf16x8*)(kp1 + 32 * ((s2) + j)); } ATT_SB
#define ATT_KMMA(buf, s2) _Pragma("unroll") for (int j = 0; j < 2; ++j) { s0 = MFMA32(buf[2 * j], qf[(s2) + j], s0); s1 = MFMA32(buf[2 * j + 1], qf[(s2) + j], s1); } ATT_SB
            const MLAS char* vp = L + ATT_VOFF + tr_off;
            s16x4 va[8], vb[8];
#define ATT_VLOAD(buf, ks) _Pragma("unroll") for (int c = 0; c < 4; ++c) { buf[2 * c] = tr_read(vp + (16 * (ks)) * ATT_VP + 64 * c); buf[2 * c + 1] = tr_read(vp + (16 * (ks) + 8) * ATT_VP + 64 * c); } ATT_SB
#define ATT_VMMA(buf, ks) _Pragma("unroll") for (int c = 0; c < 4; ++c) O[c] = MFMA32(cat8(buf[2 * c], buf[2 * c + 1]), pf[ks], O[c]); ATT_SB
            ATT_KLOAD(ka, 0) ATT_KLOAD(kb, 2) ATT_KMMA(ka, 0) ATT_KLOAD(ka, 4) ATT_KMMA(kb, 2) ATT_KLOAD(kb, 6) ATT_KMMA(ka, 4) ATT_KLOAD(ka, 8) ATT_KMMA(kb, 6) ATT_KLOAD(kb, 10) ATT_KMMA(ka, 8) ATT_VLOAD(va, 0) ATT_KMMA(kb, 10)
            float mx = s0[0];
#pragma unroll
            for (int i = 1; i < 16; ++i) mx = fmaxf(mx, s0[i]);
#pragma unroll
            for (int i = 0; i < 16; ++i) mx = fmaxf(mx, s1[i]);
            mx = fmaxf(mx, __shfl_xor(mx, 32));
            if (__any(mx > m + 8.f)) { const float mn = fmaxf(m, mx), alpha = __builtin_amdgcn_exp2f(m - mn); m = mn; l *= alpha;
#pragma unroll
                for (int c = 0; c < 4; ++c)
#pragma unroll
                    for (int i = 0; i < 16; ++i) O[c][i] *= alpha; }
            float ps = 0.f;
#pragma unroll
            for (int i = 0; i < 16; ++i) { s0[i] = __builtin_amdgcn_exp2f(s0[i] - m); s1[i] = __builtin_amdgcn_exp2f(s1[i] - m); ps += s0[i] + s1[i]; }
            ps += __shfl_xor(ps, 32);
            l += ps;
            bf16x8 pf[4]; pf[0] = pack_step(s0, 0); pf[1] = pack_step(s0, 1); pf[2] = pack_step(s1, 0); pf[3] = pack_step(s1, 1);
            ATT_SB
            ATT_VLOAD(vb, 1) ATT_VMMA(va, 0) ATT_VLOAD(va, 2) ATT_VMMA(vb, 1) ATT_VLOAD(vb, 3) ATT_VMMA(va, 2) ATT_VMMA(vb, 3)
        }
        __syncthreads();
    }
    const float inv = __builtin_amdgcn_rcpf(l);
    const int lane2 = fresh_lane();
    bf16* orow = (bf16*)(ws + WS_AR) + (size_t)(b * SEQ + qb * 256 + w * 32 + (lane2 & 31)) * 3072 + h * 128 + 4 * (lane2 >> 5);
#pragma unroll
    for (int c = 0; c < 4; ++c)
#pragma unroll
        for (int g = 0; g < 4; ++g) { u32x2 o; o.x = cvtpk(O[c][4 * g] * inv, O[c][4 * g + 1] * inv); o.y = cvtpk(O[c][4 * g + 2] * inv, O[c][4 * g + 3] * inv); *(u32x2*)(orow + 32 * c + 8 * g) = o; }
}
constexpr int RT_QP = 288, RT_VP = 544, RT_AP = 144, RT_Q = 0, RT_K = 64 * RT_QP, RT_V = 2 * 64 * RT_QP, RT_A = RT_V + 64 * RT_VP, RT_ST = RT_A + 64 * RT_AP, RT_LDS = RT_ST + 8 * 64 * 8;
__device__ __forceinline__ bf16x8 scale8(u32x4 v, float f) {
    u32x4 o; o.x = cvtpk(__uint_as_float(v.x << 16) * f, __uint_as_float(v.x & 0xffff0000u) * f); o.y = cvtpk(__uint_as_float(v.y << 16) * f, __uint_as_float(v.y & 0xffff0000u) * f);
    o.z = cvtpk(__uint_as_float(v.z << 16) * f, __uint_as_float(v.z & 0xffff0000u) * f); o.w = cvtpk(__uint_as_float(v.w << 16) * f, __uint_as_float(v.w & 0xffff0000u) * f); return __builtin_bit_cast(bf16x8, o); }
constexpr int RT_NSEG = 8, RT_NCH = (SEQ / 64) / RT_NSEG;
template <int MODE> __device__ __forceinline__ void ret_unit(MLAS char* L, unsigned char* ws, float* rl, float* sout, int b, int h, int seg, int w) {
    const int lane = fresh_lane(), tid = w * 64 + lane, r = lane & 31, hh = lane >> 5;
    const bf16* RQ = (const bf16*)(ws + WS_RQ); const bf16* RK = (const bf16*)(ws + WS_RK); const bf16* RV = (const bf16*)(ws + WS_RV); const bf16* RG = (const bf16*)(ws + WS_RG); bf16* AR = (bf16*)(ws + WS_AR);
    const float lg = log2f(1.f - exp2f(-5.f - (float)h));
    const float cdec = exp2f(64.f * lg);
    const char* qbase = (const char*)(RQ + ((size_t)b * SEQ + seg * RT_NCH * 64) * 1024 + h * 128); const char* kbase = (const char*)(RK + ((size_t)b * SEQ + seg * RT_NCH * 64) * 1024 + h * 128);
    const char* vbase = (const char*)(RV + ((size_t)b * SEQ + seg * RT_NCH * 64) * 2048 + h * 256);
    const unsigned qoff = ((tid >> 4) * 1024 + (tid & 15) * 8) * 2, voff = ((tid >> 5) * 2048 + (tid & 31) * 8) * 2;
    const int qdst0 = (tid >> 4) * RT_QP + (tid & 15) * 16, vdst0 = RT_V + (tid >> 5) * RT_VP + (tid & 31) * 16;
    float kf[2], qs[2];
#pragma unroll
    for (int i = 0; i < 2; ++i) { const int row = (tid >> 4) + 32 * i; kf[i] = exp2f(lg * (float)(63 - row)); qs[i] = exp2f(lg * (float)(row + 1)); }
    u32x4 qreg[2], kreg[2], vreg[4];
#pragma unroll
    for (int i = 0; i < 2; ++i) { if (MODE == 1) qreg[i] = *(const u32x4*)(qbase + 65536 * i + qoff); kreg[i] = *(const u32x4*)(kbase + 65536 * i + qoff); }
#pragma unroll
    for (int i = 0; i < 4; ++i) vreg[i] = *(const u32x4*)(vbase + 65536 * i + voff);
    f32x16 S[4];
#pragma unroll
    for (int kt = 0; kt < 4; ++kt)
#pragma unroll
        for (int i = 0; i < 16; ++i) S[kt][i] = 0.f;
    float* rlu = rl + ((size_t)(b * 8 + h) * RT_NSEG) * 32768 + 32 * w + r;
    if (MODE == 1) { const float cseg = exp2f((float)(RT_NCH * 64) * lg);
        for (int g = 0; g < seg; ++g) { const float* lp = rlu + (size_t)g * 32768;
#pragma unroll
            for (int kt = 0; kt < 4; ++kt)
#pragma unroll
                for (int i = 0; i < 16; ++i) S[kt][i] = S[kt][i] * cseg + lp[(32 * kt + crow(i, hh)) * 256]; } }
    const int i16 = lane & 15, q4 = i16 >> 2, blk = (lane >> 4) & 1, p4 = i16 & 3;
    const MLAS char* trv = L + RT_V + (8 * hh + q4) * RT_VP + 64 * w + 32 * blk + 8 * p4;
    const MLAS char* trk = L + RT_K + (8 * hh + q4) * RT_QP + 32 * blk + 8 * p4;
    const float icdec = exp2f(-64.f * lg);
#define RT_SB __builtin_amdgcn_sched_barrier(0);
    for (int n = 0; n < RT_NCH; ++n) {
        __syncthreads();
#pragma unroll
        for (int i = 0; i < 2; ++i) { if (MODE == 1) *(MLAS bf16x8*)(L + RT_Q + qdst0 + 32 * RT_QP * i) = scale8(qreg[i], qs[i]); *(MLAS bf16x8*)(L + RT_K + qdst0 + 32 * RT_QP * i) = scale8(kreg[i], kf[i]); }
#pragma unroll
        for (int i = 0; i < 4; ++i) *(MLAS u32x4*)(L + vdst0 + 16 * RT_VP * i) = vreg[i];
        __syncthreads();
        if (n + 1 < RT_NCH) {
            qbase += 64 * 1024 * 2; kbase += 64 * 1024 * 2; vbase += 64 * 2048 * 2;
#pragma unroll
            for (int i = 0; i < 2; ++i) { if (MODE == 1) qreg[i] = *(const u32x4*)(qbase + 65536 * i + qoff); kreg[i] = *(const u32x4*)(kbase + 65536 * i + qoff); }
#pragma unroll
            for (int i = 0; i < 4; ++i) vreg[i] = *(const u32x4*)(vbase + 65536 * i + voff);
        }
        u32x2 gv[2][4];
        const size_t rowu = (size_t)b * SEQ + (seg * RT_NCH + n) * 64;
        if (MODE == 1) { const char* gb = (const char*)(RG + rowu * 2048 + h * 256 + 32 * w); const unsigned go = (r * 2048 + 4 * hh) * 2;
#pragma unroll
            for (int qi = 0; qi < 2; ++qi)
#pragma unroll
                for (int g = 0; g < 4; ++g) gv[qi][g] = *(const u32x2*)(gb + (32 * qi * 2048 + 8 * g) * 2 + go);
        }
        if (MODE == 1 && w < 3) {
            const int kj = w >> 1, qi = (w + 1) >> 1;
            const MLAS char* kp = L + RT_K + (32 * kj + r) * RT_QP + 16 * hh; const MLAS char* qp = L + RT_Q + (32 * qi + r) * RT_QP + 16 * hh;
            bf16x8 fk[8], fq[8];
#pragma unroll
            for (int s = 0; s < 8; ++s) { fk[s] = *(const MLAS bf16x8*)(kp + 32 * s); fq[s] = *(const MLAS bf16x8*)(qp + 32 * s); }
            RT_SB
            f32x16 a;
#pragma unroll
            for (int i = 0; i < 16; ++i) a[i] = 0.f;
#pragma unroll
            for (int s = 0; s < 8; ++s) a = MFMA32(fk[s], fq[s], a);
            RT_SB
            const int q = 32 * qi + r;
#pragma unroll
            for (int g = 0; g < 4; ++g) { float v[4];
#pragma unroll
                for (int e = 0; e < 4; ++e) { const int key = 32 * kj + 8 * g + 4 * hh + e; v[e] = key <= q ? a[4 * g + e] * icdec : 0.f; }
                u32x2 o; o.x = cvtpk(v[0], v[1]); o.y = cvtpk(v[2], v[3]); *(MLAS u32x2*)(L + RT_A + q * RT_AP + (32 * kj + 8 * g + 4 * hh) * 2) = o; }
        }
        if (MODE == 1) __syncthreads();
        s16x4 vt[8];
#pragma unroll
        for (int ks = 0; ks < 4; ++ks) { vt[2 * ks] = tr_read(trv + 16 * ks * RT_VP); vt[2 * ks + 1] = tr_read(trv + (16 * ks + 4) * RT_VP); }
        f32x16 o[2];
        s16x4 ka[8], kb[8];
#define RT_KLOAD(buf, kt) _Pragma("unroll") for (int ks = 0; ks < 4; ++ks) { buf[2 * ks] = tr_read(trk + 64 * (kt) + 16 * ks * RT_QP); buf[2 * ks + 1] = tr_read(trk + 64 * (kt) + (16 * ks + 4) * RT_QP); } RT_SB
#define RT_KMMA(buf, kt) _Pragma("unroll") for (int ks = 0; ks < 4; ++ks) S[kt] = MFMA32(cat8(buf[2 * ks], buf[2 * ks + 1]), cat8(vt[2 * ks], vt[2 * ks + 1]), S[kt]); RT_SB
        if (MODE == 1) {
            const MLAS char* ap = L + RT_A + r * RT_AP + 16 * hh;
            bf16x8 af[6];
#pragma unroll
            for (int ks = 0; ks < 4; ++ks) { if (ks < 2) af[ks] = *(const MLAS bf16x8*)(ap + 32 * ks); af[2 + ks] = *(const MLAS bf16x8*)(ap + 32 * RT_AP + 32 * ks); }
            const MLAS char* qp = L + RT_Q + r * RT_QP + 8 * hh;
            s16x4 qa[8], qb[8];
#define RT_QLOAD(buf, kt) _Pragma("unroll") for (int s = 0; s < 2; ++s) _Pragma("unroll") for (int qi = 0; qi < 2; ++qi) { const MLAS char* pp = qp + 32 * qi * RT_QP + (32 * (kt) + 16 * s) * 2; buf[4 * s + 2 * qi] = *(const MLAS s16x4*)pp; buf[4 * s + 2 * qi + 1] = *(const MLAS s16x4*)(pp + 16); } RT_SB
#define RT_QMMA(buf, kt) _Pragma("unroll") for (int s = 0; s < 2; ++s) { const bf16x8 sf = pack_step(S[kt], s); _Pragma("unroll") for (int qi = 0; qi < 2; ++qi) o[qi] = MFMA32(sf, cat8(buf[4 * s + 2 * qi], buf[4 * s + 2 * qi + 1]), o[qi]); } RT_SB
            RT_QLOAD(qa, 0)
#pragma unroll
            for (int qi = 0; qi < 2; ++qi)
#pragma unroll
                for (int i = 0; i < 16; ++i) o[qi][i] = 0.f;
#pragma unroll
            for (int ks = 0; ks < 4; ++ks) { if (ks < 2) o[0] = MFMA32(cat8(vt[2 * ks], vt[2 * ks + 1]), af[ks], o[0]); o[1] = MFMA32(cat8(vt[2 * ks], vt[2 * ks + 1]), af[2 + ks], o[1]); }
            RT_SB
            RT_QLOAD(qb, 1) RT_QMMA(qa, 0) RT_QLOAD(qa, 2) RT_QMMA(qb, 1) RT_QLOAD(qb, 3) RT_QMMA(qa, 2) RT_KLOAD(ka, 0) RT_QMMA(qb, 3)
        } else { RT_KLOAD(ka, 0) }
#pragma unroll
        for (int kt = 0; kt < 4; ++kt)
#pragma unroll
            for (int i = 0; i < 16; ++i) S[kt][i] *= cdec;
        RT_SB
        RT_KLOAD(kb, 1) RT_KMMA(ka, 0) RT_KLOAD(ka, 2) RT_KMMA(kb, 1) RT_KLOAD(kb, 3) RT_KMMA(ka, 2) RT_KMMA(kb, 3)
        if (MODE == 1) {
#pragma unroll
        for (int qi = 0; qi < 2; ++qi) { float a1 = 0.f, a2 = 0.f;
#pragma unroll
            for (int i = 0; i < 16; ++i) { const float ov = o[qi][i]; a1 += ov; a2 += ov * ov; }
            a1 += __shfl_xor(a1, 32); a2 += __shfl_xor(a2, 32);
            if (hh == 0) *(MLAS f32x2_t*)(L + RT_ST + (w * 64 + 32 * qi + r) * 8) = (f32x2_t){a1, a2}; }
        __syncthreads();
#pragma unroll
        for (int qi = 0; qi < 2; ++qi) { float t1 = 0.f, t2 = 0.f;
#pragma unroll
            for (int ww = 0; ww < 8; ++ww) { const f32x2_t t = *(const MLAS f32x2_t*)(L + RT_ST + (ww * 64 + 32 * qi + r) * 8); t1 += t[0]; t2 += t[1]; }
            const float mu = t1 * (1.f / 256.f), var = t2 * (1.f / 256.f) - mu * mu, rstd = rsqrtf(var + GN_EPS);
            bf16* op = (bf16*)((char*)(AR + (rowu + 32 * qi) * 3072 + 1024 + h * 256 + 32 * w) + (unsigned)((r * 3072 + 4 * hh) * 2));
#pragma unroll
            for (int g = 0; g < 4; ++g) { const u32x2 gvv = gv[qi][g];
                u32x2 ov; ov.x = cvtpk((o[qi][4 * g] - mu) * rstd * __uint_as_float(gvv.x << 16), (o[qi][4 * g + 1] - mu) * rstd * __uint_as_float(gvv.x & 0xffff0000u));
                ov.y = cvtpk((o[qi][4 * g + 2] - mu) * rstd * __uint_as_float(gvv.y << 16), (o[qi][4 * g + 3] - mu) * rstd * __uint_as_float(gvv.y & 0xffff0000u));
                *(u32x2*)(op + 8 * g) = ov; } }
        }
    }
    if (MODE == 0 || seg == RT_NSEG - 1) { float* dst = MODE == 0 ? rlu + (size_t)seg * 32768 : sout + 32 * w + r;
#pragma unroll
        for (int kt = 0; kt < 4; ++kt)
#pragma unroll
            for (int i = 0; i < 16; ++i) dst[(size_t)(32 * kt + crow(i, hh)) * 256] = S[kt][i]; }
}
constexpr int SA_FLOATS = 128 + 64 + 512 + (PAST_LEN + DEC_SEQ) + 512 + 8;
__device__ __forceinline__ float half_sum(float v, MLAS float* red, int t) {
    for (int o = 32; o >= 1; o >>= 1) v += __shfl_xor(v, o);
    __syncthreads(); if ((t & 63) == 0) red[t >> 6] = v; __syncthreads();
    return (red[0] + red[1]) + (red[2] + red[3]);
}
__device__ __forceinline__ void sample_attn_item(MLAS float* Lh, const unsigned char* ws, const float* cache_c, const float* cache_kr, const float* newc, const float* newkr, const float* wuk, const float* wuv,
                                                 int b, int tok, int h, int t) {
    MLAS float *qn = Lh, *qr = Lh + 128, *ql = Lh + 192, *sc = Lh + 704, *ol = Lh + 704 + PAST_LEN + DEC_SEQ, *red = ol + 512;
    const bf16* Q = (const bf16*)(ws + WS_Q); bf16* AR = (bf16*)(ws + WS_AR);
    const int row = MP + b * DEC_SEQ + tok, NK = PAST_LEN + DEC_SEQ;
    __syncthreads();
    if (t < 192) Lh[t] = bf2f(Q[(size_t)row * 1536 + h * 192 + t]);
    __syncthreads();
    for (int r = t; r < 512; r += 256) { float s = 0.f; const float* wp = wuk + (size_t)r * 1024 + h * 128; for (int d = 0; d < 128; ++d) s += qn[d] * wp[d]; ql[r] = s; }
    __syncthreads();
    float mx = -1e30f;
    for (int k = t; k < NK; k += 256) {
        const float* c = k < PAST_LEN ? cache_c + ((size_t)b * PAST_LEN + k) * 512 : newc + ((size_t)b * DEC_SEQ + (k - PAST_LEN)) * 512;
        const float* kr = k < PAST_LEN ? cache_kr + ((size_t)b * PAST_LEN + k) * 64 : newkr + ((size_t)b * DEC_SEQ + (k - PAST_LEN)) * 64;
        float s = 0.f; for (int r = 0; r < 512; ++r) s += ql[r] * c[r]; for (int e = 0; e < 64; ++e) s += qr[e] * kr[e];
        sc[k] = s; mx = fmaxf(mx, s); }
    for (int o = 32; o >= 1; o >>= 1) mx = fmaxf(mx, __shfl_xor(mx, o));
    __syncthreads(); if ((t & 63) == 0) red[t >> 6] = mx; __syncthreads();
    mx = fmaxf(fmaxf(red[0], red[1]), fmaxf(red[2], red[3]));
    float ls = 0.f;
    for (int k = t; k < NK; k += 256) { const float p = exp2f(sc[k] - mx); sc[k] = p; ls += p; }
    ls = half_sum(ls, red, t);
    const float inv = 1.f / ls;
    for (int r = t; r < 512; r += 256) { float s = 0.f;
        for (int k = 0; k < NK; ++k) { const float* c = k < PAST_LEN ? cache_c + ((size_t)b * PAST_LEN + k) * 512 : newc + ((size_t)b * DEC_SEQ + (k - PAST_LEN)) * 512; s += sc[k] * c[r]; }
        ol[r] = s * inv; }
    __syncthreads();
    if (t < 128) { float s = 0.f; for (int r = 0; r < 512; ++r) s += ol[r] * wuv[(size_t)r * 1024 + h * 128 + t]; AR[(size_t)row * 3072 + h * 128 + t] = f2bf(s); }
}
__device__ __forceinline__ void sample_ret_item(MLAS float* Lh, const unsigned char* ws, const float* S0, float* Sout, int bh, int t) {
    const bf16* RQ = (const bf16*)(ws + WS_RQ); const bf16* RK = (const bf16*)(ws + WS_RK); const bf16* RV = (const bf16*)(ws + WS_RV); const bf16* RG = (const bf16*)(ws + WS_RG); bf16* AR = (bf16*)(ws + WS_AR);
    const int b = bh >> 3, h = bh & 7, wv = t >> 6;
    const float g = 1.f - exp2f(-5.f - (float)h);
    MLAS float* osh = Lh + 128;
    MLAS unsigned* qk = (MLAS unsigned*)((MLAS char*)Lh + 40960);
#pragma unroll
    for (int i = 0; i < 2; ++i) { const int c = t + 256 * i, tok = c >> 5, part = c & 31; const size_t row = (size_t)(MP + b * DEC_SEQ + tok) * 1024 + h * 128;
        *(MLAS u32x4*)(qk + tok * 128 + part * 4) = part < 16 ? *(const u32x4*)(RQ + row + part * 8) : *(const u32x4*)(RK + row + (part - 16) * 8); }
    float S[128];
#pragma unroll
    for (int d = 0; d < 128; ++d) S[d] = S0[((size_t)bh * 128 + d) * 256 + t];
    __syncthreads();
    const bf16* rvp = RV + (size_t)(MP + b * DEC_SEQ) * 2048 + h * 256 + t; float vnext = bf2f(rvp[0]);
#pragma unroll 1
    for (int tk = 0; tk < DEC_SEQ; ++tk) {
        const float v = vnext; vnext = bf2f(rvp[(size_t)(tk + 1 < DEC_SEQ ? tk + 1 : tk) * 2048]);
        const MLAS unsigned* q = qk + tk * 128; const MLAS unsigned* k = q + 64; float acc = 0.f;
#pragma unroll
        for (int d2 = 0; d2 < 64; ++d2) { const unsigned kk = k[d2], qq = q[d2];
            S[2 * d2] = g * S[2 * d2] + __uint_as_float(kk << 16) * v; acc += __uint_as_float(qq << 16) * S[2 * d2];
            S[2 * d2 + 1] = g * S[2 * d2 + 1] + __uint_as_float(kk & 0xffff0000u) * v; acc += __uint_as_float(qq & 0xffff0000u) * S[2 * d2 + 1]; }
        osh[tk * 256 + t] = acc;
        float s1 = acc, s2 = acc * acc;
#pragma unroll
        for (int x = 32; x >= 1; x >>= 1) { s1 += __shfl_xor(s1, x); s2 += __shfl_xor(s2, x); }
        if ((t & 63) == 0) { Lh[(wv * DEC_SEQ + tk) * 2] = s1; Lh[(wv * DEC_SEQ + tk) * 2 + 1] = s2; }
    }
#pragma unroll
    for (int d = 0; d < 128; ++d) Sout[((size_t)bh * 128 + d) * 256 + t] = S[d];
    __syncthreads();
#pragma unroll 1
    for (int tk = 0; tk < DEC_SEQ; ++tk) { float s1 = 0.f, s2 = 0.f;
#pragma unroll
        for (int ww = 0; ww < 4; ++ww) { s1 += Lh[(ww * DEC_SEQ + tk) * 2]; s2 += Lh[(ww * DEC_SEQ + tk) * 2 + 1]; }
        const float mu = s1 * (1.f / 256.f), var = s2 * (1.f / 256.f) - mu * mu, rstd = rsqrtf(var + GN_EPS); const int row = MP + b * DEC_SEQ + tk;
        AR[(size_t)row * 3072 + 1024 + h * 256 + t] = f2bf(bf2f(RG[(size_t)row * 2048 + h * 256 + t]) * (osh[tk * 256 + t] - mu) * rstd); }
}
constexpr int SM_CP = 1168, SM_NT = 33, SM_ROWS = 64 * SM_NT;
typedef float f32x4m __attribute__((ext_vector_type(4)));
#define MFMA16(a, b, c) __builtin_amdgcn_mfma_f32_16x16x32_bf16((a), (b), (c), 0, 0, 0)
__device__ __forceinline__ bf16x8 pack44(const f32x4m& a, const f32x4m& b) { u32x4 p; p.x = cvtpk(a[0], a[1]); p.y = cvtpk(a[2], a[3]); p.z = cvtpk(b[0], b[1]); p.w = cvtpk(b[2], b[3]); return __builtin_bit_cast(bf16x8, p); }
__device__ __forceinline__ void sample_attn_unit(MLAS char* L, unsigned char* ws, const float* wuk, const float* wuv, int b, int hg, int w) {
    const int lane = fresh_lane(), tid = w * 64 + lane, c16 = lane & 15, kg = lane >> 4;
    const int head = 4 * hg + (w & 3), rh = w >> 2, rbase = 256 * rh;
    const bf16* Q = (const bf16*)(ws + WS_Q); const bf16* CALL = (const bf16*)(ws + WS_CALL) + (size_t)b * SM_ROWS * 576; bf16* AR = (bf16*)(ws + WS_AR);
    const size_t qrow = (size_t)(MP + b * DEC_SEQ + c16) * 1536 + head * 192;
    bf16x8 qlf[16];
    {
        bf16x8 qnf[4];
#pragma unroll
        for (int s = 0; s < 4; ++s) qnf[s] = *(const bf16x8*)(Q + qrow + 32 * s + 8 * kg);
#pragma unroll
        for (int s2 = 0; s2 < 16; ++s2) { f32x4m a0 = {0.f, 0.f, 0.f, 0.f}, a1 = {0.f, 0.f, 0.f, 0.f};
            f32x4m wl[4][4];
#pragma unroll
            for (int s = 0; s < 4; ++s) { const float* p0 = wuk + (size_t)(32 * s2 + c16) * 1024 + head * 128 + 32 * s + 8 * kg; const float* p1 = p0 + 16 * 1024;
                wl[s][0] = *(const f32x4m*)p0; wl[s][1] = *(const f32x4m*)(p0 + 4); wl[s][2] = *(const f32x4m*)p1; wl[s][3] = *(const f32x4m*)(p1 + 4); }
            __builtin_amdgcn_sched_barrier(0);
#pragma unroll
            for (int s = 0; s < 4; ++s) { a0 = MFMA16(pack44(wl[s][0], wl[s][1]), qnf[s], a0); a1 = MFMA16(pack44(wl[s][2], wl[s][3]), qnf[s], a1); }
            __builtin_amdgcn_sched_barrier(0);
            qlf[s2] = pack44(a0, a1); }
    }
    MLAS char* const qrl = L + 76800 + w * 2048 + lane * 16;
    __syncthreads();
#pragma unroll
    for (int s = 0; s < 2; ++s) *(MLAS bf16x8*)(qrl + 1024 * s) = *(const bf16x8*)(Q + qrow + 128 + 32 * s + 8 * kg);
    const char* cbase = (const char*)CALL; const unsigned coff = tid * 16;
    u32x4 sreg[9];
#pragma unroll
    for (int i = 0; i < 9; ++i) sreg[i] = *(const u32x4*)(cbase + 8192 * i + coff);
    f32x4m O[16];
#pragma unroll
    for (int rt = 0; rt < 16; ++rt) O[rt] = (f32x4m){0.f, 0.f, 0.f, 0.f};
    float m = -1e30f, l = 0.f;
    const int i16 = lane & 15;
    const MLAS char* kp0 = L + c16 * SM_CP + 8 * kg;
    const MLAS char* vp0 = L + (4 * kg + (i16 >> 2)) * SM_CP + rbase * 2 + 8 * (i16 & 3);
#define SM_SB __builtin_amdgcn_sched_barrier(0);
    for (int kt = 0; kt < SM_NT; ++kt) {
        __syncthreads();
        { const int tid2 = w * 64 + fresh_lane();
#pragma unroll
          for (int i = 0; i < 9; ++i) { const int c = tid2 + 512 * i, key = c / 72; *(MLAS u32x4*)(L + c * 16 + key * (SM_CP - 1152)) = sreg[i]; } }
        __syncthreads();
        if (kt + 1 < SM_NT) { cbase += 64 * 576 * 2;
#pragma unroll
            for (int i = 0; i < 4; ++i) sreg[i] = *(const u32x4*)(cbase + 8192 * i + coff); }
        f32x4m s[4]; s16x4 kbuf[2][8], vbuf[3][4]; bf16x8 rf[2], qr[2];
#define SM_KLOAD(buf, f) _Pragma("unroll") for (int j = 0; j < 4; ++j) { const MLAS char* pp = kp0 + 16 * ((f) >> 2) * SM_CP + 64 * (4 * ((f) & 3) + j); buf[2 * j] = *(const MLAS s16x4*)pp; buf[2 * j + 1] = *(const MLAS s16x4*)(pp + 32); }
#define SM_VLOAD(buf, rt) { const MLAS char* pp = vp0 + 32 * (rt); buf[0] = tr_read(pp); buf[1] = tr_read(pp + 16 * SM_CP); buf[2] = tr_read(pp + 32 * SM_CP); buf[3] = tr_read(pp + 48 * SM_CP); }
        SM_KLOAD(kbuf[0], 0) SM_SB
#pragma unroll
        for (int f = 0; f < 16; ++f) { const int mt = f >> 2, q = f & 3;
            if (f < 15) { SM_KLOAD(kbuf[(f + 1) & 1], f + 1) } else { SM_VLOAD(vbuf[0], 0) SM_VLOAD(vbuf[1], 1) }
            if (q == 3) { const MLAS char* rp = L + (16 * mt + c16) * SM_CP + (512 + 8 * kg) * 2; rf[0] = *(const MLAS bf16x8*)rp; rf[1] = *(const MLAS bf16x8*)(rp + 64); qr[0] = *(const MLAS bf16x8*)qrl; qr[1] = *(const MLAS bf16x8*)(qrl + 1024); }
            SM_SB
            if (q == 0) s[mt] = (f32x4m){0.f, 0.f, 0.f, 0.f};
#pragma unroll
            for (int j = 0; j < 4; ++j) s[mt] = MFMA16(cat8(kbuf[f & 1][2 * j], kbuf[f & 1][2 * j + 1]), qlf[4 * q + j], s[mt]);
            if (q == 3) { s[mt] = MFMA16(rf[0], qr[0], s[mt]); s[mt] = MFMA16(rf[1], qr[1], s[mt]); }
            SM_SB
        }
        if (kt == SM_NT - 1) { s[1] = (f32x4m){-1e30f, -1e30f, -1e30f, -1e30f}; s[2] = s[1]; s[3] = s[1]; }
        float mx = -1e30f;
#pragma unroll
        for (int mt = 0; mt < 4; ++mt) mx = fmaxf(mx, fmaxf(fmaxf(s[mt][0], s[mt][1]), fmaxf(s[mt][2], s[mt][3])));
        mx = fmaxf(mx, __shfl_xor(mx, 16)); mx = fmaxf(mx, __shfl_xor(mx, 32));
        if (__any(mx > m)) { const float mn = fmaxf(m, mx), alpha = __builtin_amdgcn_exp2f(m - mn); m = mn; l *= alpha;
#pragma unroll
            for (int rt = 0; rt < 16; ++rt) O[rt] *= alpha; }
        float ps = 0.f;
#pragma unroll
        for (int mt = 0; mt < 4; ++mt)
#pragma unroll
            for (int i = 0; i < 4; ++i) { s[mt][i] = __builtin_amdgcn_exp2f(s[mt][i] - m); ps += s[mt][i]; }
        ps += __shfl_xor(ps, 16); ps += __shfl_xor(ps, 32);
        l += ps;
        const bf16x8 pf0 = pack44(s[0], s[1]), pf1 = pack44(s[2], s[3]);
        SM_SB
        if (kt + 1 < SM_NT) {
#pragma unroll
            for (int i = 4; i < 9; ++i) sreg[i] = *(const u32x4*)(cbase + 8192 * i + coff); }
        SM_SB
#pragma unroll
        for (int rt = 0; rt < 16; ++rt) {
            if (rt < 14) { SM_VLOAD(vbuf[(rt + 2) % 3], rt + 2) }
            SM_SB
            O[rt] = MFMA16(cat8(vbuf[rt % 3][0], vbuf[rt % 3][1]), pf0, O[rt]); O[rt] = MFMA16(cat8(vbuf[rt % 3][2], vbuf[rt % 3][3]), pf1, O[rt]);
            SM_SB
        }
    }
    const float invl = 1.f / l;
    const int lane3 = fresh_lane(), c16b = lane3 & 15, kgb = lane3 >> 4;
    bf16x8 of[8];
#pragma unroll
    for (int s3 = 0; s3 < 8; ++s3) of[s3] = pack44(O[2 * s3] * invl, O[2 * s3 + 1] * invl);
    f32x4m acc[8];
    const char* wvb = (const char*)(wuv + (size_t)rbase * 1024 + head * 128); const unsigned wvo = (4 * kgb * 1024 + c16b) * 4;
#pragma unroll
    for (int dt = 0; dt < 8; ++dt) { acc[dt] = (f32x4m){0.f, 0.f, 0.f, 0.f};
#pragma unroll
        for (int hs = 0; hs < 2; ++hs) {
            f32x4m wlo[4], whi[4];
#pragma unroll
            for (int s4 = 0; s4 < 4; ++s4) { const char* wp = wvb + ((size_t)(32 * (4 * hs + s4)) * 1024 + 16 * dt) * 4;
#define SM_WL(k) (*(const float*)(wp + (size_t)(k) * 4096 + wvo))
                wlo[s4] = (f32x4m){SM_WL(0), SM_WL(1), SM_WL(2), SM_WL(3)}; whi[s4] = (f32x4m){SM_WL(16), SM_WL(17), SM_WL(18), SM_WL(19)}; }
            __builtin_amdgcn_sched_barrier(0);
#pragma unroll
            for (int s4 = 0; s4 < 4; ++s4) acc[dt] = MFMA16(pack44(wlo[s4], whi[s4]), of[4 * hs + s4], acc[dt]);
            __builtin_amdgcn_sched_barrier(0); } }
    const int lane4 = fresh_lane(), c16c = lane4 & 15, kgc = lane4 >> 4;
    __syncthreads();
    MLAS f32x4m* X = (MLAS f32x4m*)L + ((w & 3) * 8) * 64 + lane4;
    if (rh == 1) {
#pragma unroll
        for (int dt = 0; dt < 8; ++dt) X[dt * 64] = acc[dt]; }
    __syncthreads();
    if (rh == 0) { bf16* op = AR + (size_t)(MP + b * DEC_SEQ + c16c) * 3072 + head * 128 + 4 * kgc;
#pragma unroll
        for (int dt = 0; dt < 8; ++dt) { const f32x4m v = acc[dt] + X[dt * 64]; u32x2 o; o.x = cvtpk(v[0], v[1]); o.y = cvtpk(v[2], v[3]); *(u32x2*)(op + 16 * dt) = o; } }
}
}

namespace mk {
#define GAS __attribute__((address_space(1)))
#define LAS __attribute__((address_space(3)))
typedef unsigned v4u __attribute__((ext_vector_type(4)));
typedef float f32x4 __attribute__((ext_vector_type(4)));
typedef GAS unsigned gu32;
#define LDS_WAIT() asm volatile("s_waitcnt lgkmcnt(0)" ::: "memory")
#define VM_WAIT() asm volatile("s_waitcnt vmcnt(0)" ::: "memory")
constexpr int NWAVES = 8;
constexpr int RING_OFF = 0, RING_BYTES = 131072, LDSCTL_OFF = RING_BYTES, MISC_OFF = LDSCTL_OFF + 320, LDS_BYTES = 147456;
constexpr int CW_BAR = 4096;
constexpr int CW_QUEUE = 8192;

#define XB_TMO      128
#define XB_XCNT(j)  (256  + 64 * (j))
#define XB_XSUB(j)  (1280 + 64 * (j))
#define XB_XGEN(j)  (2304 + 64 * (j))
#define XB_TOP      3328
#define XB_TOPGEN   3392
#define XCD_BAR_WORDS 3456
#define XB_SPIN_CAP (1u << 18)

__device__ __forceinline__ unsigned xb_ld(unsigned* p)              { return __hip_atomic_load(p, __ATOMIC_RELAXED, __HIP_MEMORY_SCOPE_AGENT); }
__device__ __forceinline__ unsigned xb_add(unsigned* p, unsigned v) { return __hip_atomic_fetch_add(p, v, __ATOMIC_RELAXED, __HIP_MEMORY_SCOPE_AGENT); }
__device__ __forceinline__ unsigned xb_xcc_id() { return (unsigned)__builtin_amdgcn_s_getreg((3 << 11) | 20) & 0xFu; }
#define XB_SPIN(cond, bar) do { unsigned _sp = 0; while (cond) { __builtin_amdgcn_s_sleep(1); \
    if ((++_sp & 255u) == 0u) { if (xb_ld(&(bar)[XB_TMO])) break; if (_sp > XB_SPIN_CAP) { atomicAdd(&(bar)[XB_TMO], 1u); break; } } } } while (0)

struct XcdBarrier {
    unsigned* bar; unsigned x;
    volatile LAS unsigned* st;
};

__device__ __forceinline__ XcdBarrier xcd_barrier_post(unsigned* bar, volatile LAS unsigned* st) {
    XcdBarrier b; b.bar = bar; b.x = xb_xcc_id(); b.st = st;
    if (threadIdx.x == 0) (void)xb_add(&bar[XB_XCNT(b.x)], 1u);
    return b;
}
__device__ __forceinline__ void xcd_barrier_complete(unsigned* bar, unsigned x, unsigned& nloc, unsigned& nx) {
    const unsigned G = gridDim.x * gridDim.y * gridDim.z;
    unsigned sum, cnt, mine, sp = 0u;
    for (;;) {
        sum = 0u; cnt = 0u; mine = 0u;
#pragma unroll
        for (unsigned j = 0; j < 16; ++j) { const unsigned c = xb_ld(&bar[XB_XCNT(j)]); sum += c; cnt += (c > 0u) ? 1u : 0u; mine = (j == x) ? c : mine; }
        if (sum == G) break;
        __builtin_amdgcn_s_sleep(1);
        if ((++sp & 255u) == 0u) { if (xb_ld(&bar[XB_TMO])) break; if (sp > XB_SPIN_CAP) { atomicAdd(&bar[XB_TMO], 1u); break; } }
    }
    nloc = mine > 0u ? mine : 1u; nx = cnt > 0u ? cnt : 1u;
}

__device__ __forceinline__ void xcd_barrier(const XcdBarrier& b) {
    asm volatile("s_waitcnt vmcnt(0)" ::: "memory");
    __syncthreads();
    if (threadIdx.x == 0) {
        unsigned* bar = b.bar;
        __builtin_amdgcn_s_waitcnt(0);
        unsigned nloc = b.st[0], nx = b.st[1];
        if (nloc == 0u) { xcd_barrier_complete(bar, b.x, nloc, nx); b.st[0] = nloc; b.st[1] = nx; }
        const unsigned old = xb_add(&bar[XB_XSUB(b.x)], 1u);
        const unsigned gen = old / nloc;
        if (old + 1u == (gen + 1u) * nloc) {
            __builtin_amdgcn_fence(__ATOMIC_RELEASE, "agent");
            asm volatile("s_waitcnt vmcnt(0)" ::: "memory");
            const unsigned og = xb_add(&bar[XB_TOP], 1u);
            const unsigned tg = og / nx;
            if (og + 1u == (tg + 1u) * nx) xb_add(&bar[XB_TOPGEN], 1u);
            else XB_SPIN(xb_ld(&bar[XB_TOPGEN]) == tg, bar);
            __builtin_amdgcn_fence(__ATOMIC_ACQUIRE, "agent");
            xb_add(&bar[XB_XGEN(b.x)], 1u);
            asm volatile("s_waitcnt vmcnt(0)" ::: "memory");
        } else {
            XB_SPIN(xb_ld(&bar[XB_XGEN(b.x)]) == gen, bar);
            __builtin_amdgcn_fence(__ATOMIC_ACQUIRE, "agent");
            asm volatile("s_waitcnt vmcnt(0)" ::: "memory");
        }
    }
    __syncthreads();
}


enum { MAT_W13 = 0, MAT_L8 = 1, MAT_WIN = 2, MAT_WUQ = 3 };
__host__ __device__ inline int l8(int j) { const int t = j >> 8, jj = j & 255, bj = jj >> 7, wc = (jj >> 5) & 3, n = (jj >> 4) & 1, fq = (jj >> 2) & 3, e = jj & 3; return t * 256 + 128 * bj + 32 * wc + 8 * fq + 4 * n + e; }
__host__ __device__ inline int map_src(int mat, int j) {
    const int t = j >> 8, jj = j & 255, bj = jj >> 7, wc = (jj >> 5) & 3, n = (jj >> 4) & 1, fq = (jj >> 2) & 3, e = jj & 3;
    switch (mat) {
    case MAT_W13: return bj * D_FF + 128 * t + 32 * wc + 8 * fq + 4 * n + e;
    case MAT_L8: return l8(j);
    case MAT_WIN:
        if (t < 4) return l8(j);
        if (t < 12) { const int base = t < 8 ? CO_RQ : CO_RK, head = 2 * ((t - 4) & 3) + (wc >> 1), idx = 32 * (wc & 1) + 8 * fq + 4 * bj + e; return base + head * 128 + 64 * n + idx; }
        if (t < 44) return CO_RV + l8(j - 12 * 256);
        return (bj == 0 && wc < 2) ? CO_KR + 32 * n + 16 * wc + 4 * fq + e : -1;
    default:
        if (t < 4) { const int f = 128 * bj + 32 * wc + 8 * fq + 4 * n + e; return (2 * t + (f >> 7)) * 192 + (f & 127); }
        { const int head = 4 * (t - 4) + wc, idx = 8 * fq + 4 * bj + e; return head * 192 + 128 + 32 * n + idx; }
    }
}
constexpr int NT_W13 = 11264, NT_WIN = 11520, NT_WUQ = 1536;
constexpr size_t WT_W13A = 0, WT_W2A = WT_W13A + (size_t)NT_W13 * 2048 * 2, WT_WIN = WT_W2A + (size_t)2048 * D_FF * 2, WT_WUQ = WT_WIN + (size_t)NT_WIN * 2048 * 2,
                 WT_WUKV = WT_WUQ + (size_t)NT_WUQ * 512 * 2, WT_W67 = WT_WUKV + (size_t)2048 * 512 * 2, WT_WOUT = WT_W67 + (size_t)2048 * 3072 * 2, WT_W13B = WT_WOUT + (size_t)2048 * 2048 * 2,
                 WT_W2B = WT_W13B + (size_t)NT_W13 * 2048 * 2, WT_BYTES = WT_W2B + (size_t)2048 * D_FF * 2;
constexpr int NI_W13 = 16 * (NT_W13 / 32), NI_W2 = 44 * 64, NI_WIN = 16 * (NT_WIN / 32), NI_WUQ = 4 * (NT_WUQ / 32), NI_WUKV = 4 * 64, NI_W67 = 24 * 64, NI_WOUT = 16 * 64;
constexpr int NI_LAYER = 2 * NI_W13 + 2 * NI_W2 + NI_WIN + NI_WUQ + NI_WUKV + NI_W67 + NI_WOUT;

__device__ __forceinline__ unsigned f2bf_u(float f) { unsigned u = __builtin_bit_cast(unsigned, f); return (u + 0x7fffu + ((u >> 16) & 1u)) >> 16; }
__device__ __forceinline__ unsigned pk2(float lo, float hi) { typedef float f2_t __attribute__((ext_vector_type(2))); typedef __bf16 b2_t __attribute__((ext_vector_type(2))); f2_t v = {lo, hi}; return __builtin_bit_cast(unsigned, __builtin_convertvector(v, b2_t)); }
__device__ __forceinline__ float wave_sum(float v) {
#pragma unroll
    for (int o = 1; o < 64; o <<= 1) v += __shfl_xor(v, o);
    return v;
}
__device__ __forceinline__ void conv_item(const float* W, int ldw, const float* gain, int k0, int src4, bf16* BtRow0, int Kbt, int dst_step, LAS float* scr, int lane) {
    const int jl = lane & 7, kr = lane >> 3;
    f32x4 v[16];
#pragma unroll
    for (int i = 0; i < 16; ++i) { const int kk = kr + 8 * i; v[i] = src4 >= 0 ? *(const f32x4*)(W + (size_t)(k0 + kk) * ldw + src4) : (f32x4){0.f, 0.f, 0.f, 0.f}; }
#pragma unroll
    for (int h = 0; h < 2; ++h) {
#pragma unroll
        for (int i = 0; i < 8; ++i) { const int kk = kr + 8 * i; const float g = gain ? gain[k0 + 64 * h + kk] : 1.f; LAS float* d = scr + kk * 33 + 4 * jl; d[0] = v[8 * h + i][0] * g; d[1] = v[8 * h + i][1] * g; d[2] = v[8 * h + i][2] * g; d[3] = v[8 * h + i][3] * g; }
        LDS_WAIT(); asm volatile("" ::: "memory");
        const int c = lane & 7;
#pragma unroll
        for (int j = 0; j < 4; ++j) { const int n = (lane >> 3) + 8 * j; const LAS float* sp = scr + (8 * c) * 33 + n;
            v4u o; o.x = pk2(sp[0 * 33], sp[1 * 33]); o.y = pk2(sp[2 * 33], sp[3 * 33]); o.z = pk2(sp[4 * 33], sp[5 * 33]); o.w = pk2(sp[6 * 33], sp[7 * 33]);
            *(GAS v4u*)(BtRow0 + (size_t)h * dst_step + (size_t)n * Kbt + 8 * c) = o; }
        LDS_WAIT(); asm volatile("" ::: "memory");
    }
}
struct LayerW { const float *f1n, *f1w13, *f1w2, *mixn, *win, *qn, *kvn, *wuq, *wuk, *wuv, *wmo, *wro, *wout, *f2n, *f2w13, *f2w2; };
__device__ __forceinline__ void conv_dispatch(const LayerW& w, unsigned char* wt, int it, LAS float* scr, int lane) {
    int r = it; const int jl = 4 * (lane & 7);
    if (r < NI_W13) { const int kb = r / 352, j0 = 32 * (r % 352); conv_item(w.f1w13, 2 * D_FF, w.f1n, 128 * kb, map_src(MAT_W13, j0 + jl), (bf16*)(wt + WT_W13A) + (size_t)j0 * 2048 + 128 * kb, 2048, 64, scr, lane); return; } r -= NI_W13;
    if (r < NI_W2) { const int kb = r / 64, j0 = 32 * (r % 64); conv_item(w.f1w2, 2048, nullptr, 128 * kb, l8(j0 + jl), (bf16*)(wt + WT_W2A) + ((size_t)((j0 >> 8) * 88 + 2 * kb) * 256 + (j0 & 255)) * 64, 64, 256 * 64, scr, lane); return; } r -= NI_W2;
    if (r < NI_WIN) { const int kb = r / 360, j0 = 32 * (r % 360); conv_item(w.win, IN_WIDTH, w.mixn, 128 * kb, map_src(MAT_WIN, j0 + jl), (bf16*)(wt + WT_WIN) + (size_t)j0 * 2048 + 128 * kb, 2048, 64, scr, lane); return; } r -= NI_WIN;
    if (r < NI_WUQ) { const int kb = r / 48, j0 = 32 * (r % 48); conv_item(w.wuq, 1536, w.qn, 128 * kb, map_src(MAT_WUQ, j0 + jl), (bf16*)(wt + WT_WUQ) + (size_t)j0 * 512 + 128 * kb, 512, 64, scr, lane); return; } r -= NI_WUQ;
    if (r < NI_WUKV) { const int kb = r / 64, j0 = 32 * (r % 64); const bool isv = j0 >= 1024;
        conv_item(isv ? w.wuv : w.wuk, 1024, w.kvn, 128 * kb, l8((j0 & 1023) + jl), (bf16*)(wt + WT_WUKV) + (size_t)j0 * 512 + 128 * kb, 512, 64, scr, lane); return; } r -= NI_WUKV;
    if (r < NI_W67) { const int kb = r / 64, j0 = 32 * (r % 64); const bool isr = kb >= 8;
        conv_item(isr ? w.wro : w.wmo, 2048, nullptr, isr ? 128 * (kb - 8) : 128 * kb, l8(j0 + jl), (bf16*)(wt + WT_W67) + (size_t)j0 * 3072 + 128 * kb, 3072, 64, scr, lane); return; } r -= NI_W67;
    if (r < NI_WOUT) { const int kb = r / 64, j0 = 32 * (r % 64); conv_item(w.wout, 2048, nullptr, 128 * kb, l8(j0 + jl), (bf16*)(wt + WT_WOUT) + (size_t)j0 * 2048 + 128 * kb, 2048, 64, scr, lane); return; } r -= NI_WOUT;
    if (r < NI_W13) { const int kb = r / 352, j0 = 32 * (r % 352); conv_item(w.f2w13, 2 * D_FF, w.f2n, 128 * kb, map_src(MAT_W13, j0 + jl), (bf16*)(wt + WT_W13B) + (size_t)j0 * 2048 + 128 * kb, 2048, 64, scr, lane); return; } r -= NI_W13;
    { const int kb = r / 64, j0 = 32 * (r % 64); conv_item(w.f2w2, 2048, nullptr, 128 * kb, l8(j0 + jl), (bf16*)(wt + WT_W2B) + ((size_t)((j0 >> 8) * 88 + 2 * kb) * 256 + (j0 & 255)) * 64, 64, 256 * 64, scr, lane); }
}

template <int NSL> __device__ __forceinline__ void finalize_res(unsigned char* ws, float scale, int gw, int NGW) {
    const int lane = fresh_lane(); bf16* XB = (bf16*)(ws + WS_XB); float* SS = (float*)(ws + WS_SS); const float* slab = (const float*)(ws + WS_SLAB);
    for (int it = gw; it < MS * 8; it += NGW) { const int r = it >> 3, j = it & 7, c = 256 * j + 4 * lane; const size_t row = (size_t)MP + r;
        f32x4 acc = {0.f, 0.f, 0.f, 0.f};
        const uint2 xb = *(const uint2*)(XB + row * 2048 + c);
        f32x4 sl[NSL];
#pragma unroll
        for (int ks = 0; ks < NSL; ++ks) sl[ks] = *(const f32x4*)(slab + ((size_t)ks * MS + r) * 2048 + c);
#pragma unroll
        for (int ks = 0; ks < NSL; ++ks) acc += sl[ks];
        const f32x4 x = {__uint_as_float(xb.x << 16), __uint_as_float(xb.x & 0xffff0000u), __uint_as_float(xb.y << 16), __uint_as_float(xb.y & 0xffff0000u)};
        const f32x4 v = x + acc * scale;
        uint2 o; o.x = pk2(v[0], v[1]); o.y = pk2(v[2], v[3]); *(uint2*)(XB + row * 2048 + c) = o;
        const float s = wave_sum((v[0] * v[0] + v[1] * v[1]) + (v[2] * v[2] + v[3] * v[3]));
        if (lane < 4) SS[row * 32 + 4 * j + lane] = lane == 0 ? s : 0.f; }
}
__device__ __forceinline__ void finalize_gate(unsigned char* ws, int gw, int NGW) {
    const int lane = fresh_lane(); bf16* GM = (bf16*)(ws + WS_GM); const bf16* GR = (const bf16*)(ws + WS_GR); const float* slab = (const float*)(ws + WS_SLAB);
    for (int it = gw; it < MS * 8; it += NGW) { const int r = it >> 3, c = 256 * (it & 7) + 4 * lane; const size_t row = (size_t)MP + r;
        f32x4 p1 = {0.f, 0.f, 0.f, 0.f}, p2 = {0.f, 0.f, 0.f, 0.f};
#pragma unroll
        for (int ks = 0; ks < 4; ++ks) p1 += *(const f32x4*)(slab + ((size_t)ks * MS + r) * 2048 + c);
#pragma unroll
        for (int ks = 4; ks < 12; ++ks) p2 += *(const f32x4*)(slab + ((size_t)ks * MS + r) * 2048 + c);
        const uint2 gm = *(const uint2*)(GM + row * 2048 + c), gr = *(const uint2*)(GR + row * 2048 + c);
        const f32x4 a = {__uint_as_float(gm.x << 16), __uint_as_float(gm.x & 0xffff0000u), __uint_as_float(gm.y << 16), __uint_as_float(gm.y & 0xffff0000u)};
        const f32x4 b = {__uint_as_float(gr.x << 16), __uint_as_float(gr.x & 0xffff0000u), __uint_as_float(gr.y << 16), __uint_as_float(gr.y & 0xffff0000u)};
        const f32x4 v = a * p1 + b * p2; uint2 o; o.x = pk2(v[0], v[1]); o.y = pk2(v[2], v[3]); *(uint2*)(GM + row * 2048 + c) = o; }
}
enum Phase { PH_CONV = 0, PH_UP1, PH_DOWN1, PH_DOWN1F, PH_WIN, PH_QKV, PH_MIX, PH_MR, PH_MRF, PH_OUT, PH_OUTF, PH_UP2, PH_DOWN2, PH_DOWN2F, PH_PER_LAYER };
struct Args { const float* in[22]; float* out; unsigned char* ws; int l_lo, l_hi, ph_lo, ph_hi, fused, do_final; };

__global__ void __launch_bounds__(NWAVES * 64, 2) mk_fwd(Args a) {
    extern __shared__ __attribute__((aligned(16))) unsigned char lds[];
    LAS unsigned char* L = (LAS unsigned char*)lds;
    volatile LAS unsigned* MISC = (volatile LAS unsigned*)(L + MISC_OFF);
    const int wave = __builtin_amdgcn_readfirstlane((int)threadIdx.x >> 6);
    const int G = gridDim.x, bx = blockIdx.x, vcu = (G % 8 == 0) ? (bx % 8) * (G / 8) + bx / 8 : bx;
    const int gw = vcu * NWAVES + wave, NGW = G * NWAVES;
    unsigned char* ws = a.ws; unsigned* ctl = (unsigned*)(ws + WS_CTL);
    for (int u = threadIdx.x; u < (LDS_BYTES - LDSCTL_OFF) / 4; u += NWAVES * 64) ((LAS unsigned*)(L + LDSCTL_OFF))[u] = 0u;
    __syncthreads();
    XcdBarrier bar; bar.bar = ctl + CW_BAR; bar.x = 0; bar.st = nullptr;
    if (a.fused) bar = xcd_barrier_post(ctl + CW_BAR, MISC + 8);
#define SEAM() do { if (a.fused) xcd_barrier(bar); } while (0)
#define IN(k) (a.ph_lo <= (k) && (k) < a.ph_hi)
    unsigned char* wt = ws + WS_WT;
    if (IN(PH_CONV) && a.l_lo == 0 && a.l_hi > 0) {
        const int lane = fresh_lane(), tid = wave * 64 + lane;
        float* SS = (float*)(ws + WS_SS); bf16* XB = (bf16*)(ws + WS_XB); float2* t64 = (float2*)(ws + WS_ROPE64); float2* t128 = (float2*)(ws + WS_ROPE128);
        for (int m = gw; m < MT; m += NGW) {
            const float* xr = m < MP ? a.in[0] + (size_t)m * 2048 : a.in[1] + (size_t)(m - MP) * 2048; float s = 0.f; f32x4 xv[8];
#pragma unroll
            for (int j = 0; j < 8; ++j) xv[j] = *(const f32x4*)(xr + 256 * j + 4 * lane);
#pragma unroll
            for (int j = 0; j < 8; ++j) { const f32x4 v = xv[j];
                uint2 o; o.x = pk2(v[0], v[1]); o.y = pk2(v[2], v[3]); *(uint2*)(XB + (size_t)m * 2048 + 256 * j + 4 * lane) = o; s += (v[0] * v[0] + v[1] * v[1]) + (v[2] * v[2] + v[3] * v[3]); }
            s = wave_sum(s); if (lane < 32) SS[(size_t)m * 32 + lane] = lane == 0 ? s : 0.f;
        }
        for (int i = bx * 512 + tid; i < 4096 * 64; i += G * 512) {
            { const int pos = i / 64, j = i % 64; const double inv = pow(10000.0, -(2.0 * j) / 128.0), ang = (double)pos * inv; t128[i] = make_float2((float)cos(ang), (float)sin(ang)); }
            if (i < 4096 * 32) { const int pos = i / 32, j = i % 32; const double inv = pow(10000.0, -(2.0 * j) / 64.0), ang = (double)pos * inv; t64[i] = make_float2((float)cos(ang), (float)sin(ang)); }
        }
    }
    for (int l = a.l_lo; l < a.l_hi; ++l) {
        if (IN(PH_CONV)) {
            LayerW w; w.f1n = a.in[5] + (size_t)l * 2048; w.f1w13 = a.in[6] + (size_t)l * 2048 * 2 * D_FF; w.f1w2 = a.in[7] + (size_t)l * D_FF * 2048; w.mixn = a.in[8] + (size_t)l * 2048; w.win = a.in[9] + (size_t)l * 2048 * IN_WIDTH;
            w.qn = a.in[10] + (size_t)l * 512; w.kvn = a.in[11] + (size_t)l * 512; w.wuq = a.in[12] + (size_t)l * 512 * 1536; w.wuk = a.in[13] + (size_t)l * 512 * 1024; w.wuv = a.in[14] + (size_t)l * 512 * 1024;
            w.wmo = a.in[15] + (size_t)l * 1024 * 2048; w.wro = a.in[16] + (size_t)l * 2048 * 2048; w.wout = a.in[17] + (size_t)l * 2048 * 2048; w.f2n = a.in[18] + (size_t)l * 2048; w.f2w13 = a.in[19] + (size_t)l * 2048 * 2 * D_FF; w.f2w2 = a.in[20] + (size_t)l * D_FF * 2048;
            LAS float* scr = (LAS float*)(L + RING_OFF + wave * 16384); const int lane = fresh_lane();
            for (int it = gw; it < NI_LAYER; it += NGW) conv_dispatch(w, wt, it, scr, lane);
            {
                const float* cc = a.in[2] + (size_t)l * DEC_BATCH * PAST_LEN * 512; const float* ck = a.in[3] + (size_t)l * DEC_BATCH * PAST_LEN * 64; bf16* CALL = (bf16*)(ws + WS_CALL);
                int i0 = gw;
                for (; i0 + 3 * NGW < DEC_BATCH * PAST_LEN; i0 += 4 * NGW) {
                    const float* c = cc + (size_t)i0 * 512 + 8 * lane; const float* k = ck + (size_t)i0 * 64 + lane; const size_t cs = (size_t)NGW * 512, ks = (size_t)NGW * 64;
                    const f32x4 a0 = *(const f32x4*)c, a1 = *(const f32x4*)(c + 4), b0 = *(const f32x4*)(c + cs), b1 = *(const f32x4*)(c + cs + 4), c0 = *(const f32x4*)(c + 2 * cs), c1 = *(const f32x4*)(c + 2 * cs + 4), d0 = *(const f32x4*)(c + 3 * cs), d1 = *(const f32x4*)(c + 3 * cs + 4);
                    const float ka = k[0], kb = k[ks], kc = k[2 * ks], kd = k[3 * ks];
#define CALL_ROW(i, x0, x1, kx) { bf16* dst = CALL + ((size_t)((i) >> 11) * 2112 + ((i) & 2047)) * 576; v4u o; o.x = pk2(x0[0], x0[1]); o.y = pk2(x0[2], x0[3]); o.z = pk2(x1[0], x1[1]); o.w = pk2(x1[2], x1[3]); *(v4u*)(dst + 8 * lane) = o; dst[512 + lane] = (bf16)f2bf_u(kx); }
                    CALL_ROW(i0, a0, a1, ka) CALL_ROW(i0 + NGW, b0, b1, kb) CALL_ROW(i0 + 2 * NGW, c0, c1, kc) CALL_ROW(i0 + 3 * NGW, d0, d1, kd)
                }
                for (; i0 < DEC_BATCH * PAST_LEN; i0 += NGW) { const float* c = cc + (size_t)i0 * 512 + 8 * lane; const f32x4 a0 = *(const f32x4*)c, a1 = *(const f32x4*)(c + 4); const float ka = ck[(size_t)i0 * 64 + lane]; CALL_ROW(i0, a0, a1, ka) }
#undef CALL_ROW
                for (int i = gw; i < DEC_BATCH * 48; i += NGW) { bf16* dst = CALL + ((size_t)(i / 48) * 2112 + PAST_LEN + DEC_SEQ + i % 48) * 576;
                    unsigned z = 0u; asm volatile("" : "+v"(z)); *(v4u*)(dst + 8 * lane) = (v4u){z, z, z, z}; dst[512 + lane] = (bf16)z; }
            }
            SEAM();
        }
        for (int half = 0; half < 2; ++half) {
            if (IN(half ? PH_UP2 : PH_UP1)) { pg8::Gemm g{(const bf16*)(ws + WS_XB), (const bf16*)(wt + (half ? WT_W13B : WT_W13A)), MT, NT_W13, 2048, 2048, 2048}; pg8::StaticOrder S; S.init(MT, NT_W13, G, bx); pg8::EpiUp E{ws};
                pg8::gemm_phase<pg8::EpiUp, pg8::StaticOrder, true, true>(L + RING_OFF, g, S, E, wave); SEAM(); }
            if (IN(half ? PH_DOWN2 : PH_DOWN1)) {
                { pg8::Gemm g{(const bf16*)(ws + WS_HB), (const bf16*)(wt + (half ? WT_W2B : WT_W2A)), MP, 2048, D_FF, 64, 64, 32768, (size_t)(D_FF / 64) * 32768, 32768, (size_t)(D_FF / 64) * 32768}; pg8::StaticOrder S; S.init(MP, 2048, G, bx); pg8::EpiRes E{ws, 0.5f};
                  pg8::gemm_phase<pg8::EpiRes, pg8::StaticOrder, true, true>(L + RING_OFF, g, S, E, wave); }
                { pg8::Gemm g{(const bf16*)(ws + WS_HB) + (size_t)MP * D_FF, (const bf16*)(wt + (half ? WT_W2B : WT_W2A)), MS, 2048, 512, 64, 64, 32768, (size_t)(D_FF / 64) * 32768, 32768, (size_t)(D_FF / 64) * 32768}; pg8::SplitOrder S; S.init(2048, 11, 512, G, bx); pg8::EpiSlab E{(float*)(ws + WS_SLAB), 0, 512};
                  pg8::gemm_phase<pg8::EpiSlab, pg8::SplitOrder, true, true>(L + RING_OFF, g, S, E, wave); }
                SEAM();
            }
            if (IN(half ? PH_DOWN2F : PH_DOWN1F)) { finalize_res<11>(ws, 0.5f, gw, NGW);
                if (!(half == 1 && l + 1 < a.l_hi && a.fused && IN(PH_CONV))) SEAM(); }
            if (half == 0) {
            if (IN(PH_WIN)) { pg8::Gemm g{(const bf16*)(ws + WS_XB), (const bf16*)(wt + WT_WIN), MT, NT_WIN, 2048, 2048, 2048}; pg8::StaticOrder S; S.init(MT, NT_WIN, G, bx);
                pg8::EpiWin E{ws, a.out, l};
                pg8::gemm_phase<pg8::EpiWin, pg8::StaticOrder, true, true>(L + RING_OFF, g, S, E, wave); SEAM(); }
            if (IN(PH_QKV)) {
                { pg8::Gemm g{(const bf16*)(ws + WS_QL), (const bf16*)(wt + WT_WUQ), MT, NT_WUQ, 512, 512, 512}; pg8::StaticOrder S; S.init(MT, NT_WUQ, G, bx); pg8::EpiQ E{ws};
                  pg8::gemm_phase<pg8::EpiQ, pg8::StaticOrder, true, true>(L + RING_OFF, g, S, E, wave); }
                { pg8::Gemm g{(const bf16*)(ws + WS_CRB), (const bf16*)(wt + WT_WUKV), MP, 2048, 512, 512, 512}; pg8::StaticOrder S; S.init(MP, 2048, G, bx); pg8::EpiKV E{ws};
                  pg8::gemm_phase<pg8::EpiKV, pg8::StaticOrder, true, true>(L + RING_OFF, g, S, E, wave); }
                for (int u = bx; u < 32 * mix::RT_NSEG; u += G) mix::ret_unit<0>((MLAS char*)(L + RING_OFF), ws, a.out + OFF_Y, nullptr, u >> 6, (u >> 3) & 7, u & 7, wave);
                const int lane = fresh_lane(); const float* SC = (const float*)(ws + WS_SC); const bf16* CRB = (const bf16*)(ws + WS_CRB); const float* kvn = a.in[11] + (size_t)l * 512;
                int m = gw;
                for (; m + 3 * NGW < MP; m += 4 * NGW) {
                    f32x4 sa[4], sb[4]; uint2 cb[4][2];
#pragma unroll
                    for (int q = 0; q < 4; ++q) { const size_t mm = (size_t)m + (size_t)q * NGW; sa[q] = *(const f32x4*)(SC + mm * 8); sb[q] = *(const f32x4*)(SC + mm * 8 + 4); cb[q][0] = *(const uint2*)(CRB + mm * 512 + 4 * lane); cb[q][1] = *(const uint2*)(CRB + mm * 512 + 256 + 4 * lane); }
                    const f32x4 kv0 = *(const f32x4*)(kvn + 4 * lane), kv1 = *(const f32x4*)(kvn + 256 + 4 * lane);
#pragma unroll
                    for (int q = 0; q < 4; ++q) { const size_t mm = (size_t)m + (size_t)q * NGW;
                        const float rstd = rsqrtf((((sa[q][0] + sa[q][1]) + (sa[q][2] + sa[q][3])) + ((sb[q][0] + sb[q][1]) + (sb[q][2] + sb[q][3]))) * (1.f / 512.f) + NORM_EPS);
                        float* co = a.out + OFF_CKVP + ((size_t)l * MP + mm) * 512;
#pragma unroll
                        for (int j = 0; j < 2; ++j) { const uint2 c2 = cb[q][j]; const f32x4 cr = {__uint_as_float(c2.x << 16), __uint_as_float(c2.x & 0xffff0000u), __uint_as_float(c2.y << 16), __uint_as_float(c2.y & 0xffff0000u)};
                            *(f32x4*)(co + 256 * j + 4 * lane) = cr * rstd * (j ? kv1 : kv0); } }
                }
                for (; m < MT; m += NGW) {
                    const f32x4 s0 = *(const f32x4*)(SC + (size_t)m * 8), s1 = *(const f32x4*)(SC + (size_t)m * 8 + 4);
                    const float rstd = rsqrtf((((s0[0] + s0[1]) + (s0[2] + s0[3])) + ((s1[0] + s1[1]) + (s1[2] + s1[3]))) * (1.f / 512.f) + NORM_EPS);
                    float* co = m < MP ? a.out + OFF_CKVP + ((size_t)l * MP + m) * 512 : a.out + OFF_CKVS + ((size_t)l * MS + (m - MP)) * 512;
#pragma unroll
                    for (int j = 0; j < 2; ++j) { const int c = 256 * j + 4 * lane; const uint2 cb = *(const uint2*)(CRB + (size_t)m * 512 + c);
                    const f32x4 cr = {__uint_as_float(cb.x << 16), __uint_as_float(cb.x & 0xffff0000u), __uint_as_float(cb.y << 16), __uint_as_float(cb.y & 0xffff0000u)}; const f32x4 v = cr * rstd * *(const f32x4*)(kvn + c);
                        *(f32x4*)(co + c) = v; uint2 o; o.x = pk2(v[0], v[1]); o.y = pk2(v[2], v[3]);
                        if (m >= MP) *(uint2*)((bf16*)(ws + WS_CALL) + ((size_t)((m - MP) >> 4) * 2112 + PAST_LEN + ((m - MP) & 15)) * 576 + c) = o; }
                    if (m >= MP) ((bf16*)(ws + WS_CALL))[((size_t)((m - MP) >> 4) * 2112 + PAST_LEN + ((m - MP) & 15)) * 576 + 512 + lane] = ((const bf16*)(ws + WS_KR))[(size_t)m * 64 + lane];
                }
                SEAM();
            }
            if (IN(PH_MIX)) {
                const int xq = bx & 7;
                for (;;) {
                    __syncthreads();
                    if (threadIdx.x == 0) MISC[16] = __hip_atomic_fetch_add(ctl + CW_QUEUE + 64 * l + xq, 1u, __ATOMIC_RELAXED, __HIP_MEMORY_SCOPE_AGENT);
                    __syncthreads();
                    int t = (int)MISC[16];
                    if (t >= 4 + 32 + 8 + 64) break;
                    if (t < 4) { const int id = 4 * xq + t; mix::sample_attn_unit((MLAS char*)(L + RING_OFF), ws, a.in[13] + (size_t)l * 512 * 1024, a.in[14] + (size_t)l * 512 * 1024, id >> 1, id & 1, wave); }
                    else if (t < 36) { t -= 4; const int p = 4 * xq + (t >> 3), seg = t & 7; mix::ret_unit<1>((MLAS char*)(L + RING_OFF), ws, a.out + OFF_Y, a.out + OFF_RETP + ((size_t)l * 32 + p) * 32768, p >> 3, p & 7, seg, wave); }
                    else if (t < 44) { t = 8 * xq + (t - 36); const int hf = wave >> 2, tt = (wave & 3) * 64 + fresh_lane(); MLAS float* Lh = (MLAS float*)(L + RING_OFF) + hf * 4352;
                        mix::sample_ret_item(Lh, ws, a.in[4] + (size_t)l * DEC_BATCH * 8 * 128 * 256, a.out + OFF_RETS + (size_t)l * DEC_BATCH * 8 * 128 * 256, 2 * t + hf, tt); }
                    else { t -= 44; const int p = 4 * xq + (t & 3); mix::attn_unit((MLAS char*)(L + RING_OFF), ws, p >> 3, p & 7, 15 - (t >> 2), wave); }
                }
                SEAM();
            }
            if (IN(PH_MR)) {
                { pg8::Gemm g{(const bf16*)(ws + WS_AR), (const bf16*)(wt + WT_W67), MP, 2048, 1024, 3072, 3072}; pg8::StaticOrder S; S.init(MP, 2048, G, bx); pg8::EpiGate<0> E{ws};
                  pg8::gemm_phase<pg8::EpiGate<0>, pg8::StaticOrder, true, true>(L + RING_OFF, g, S, E, wave); }
                { pg8::Gemm g{(const bf16*)(ws + WS_AR) + 1024, (const bf16*)(wt + WT_W67) + 1024, MP, 2048, 2048, 3072, 3072}; pg8::StaticOrder S; S.init(MP, 2048, G, bx); pg8::EpiGate<1> E{ws};
                  pg8::gemm_phase<pg8::EpiGate<1>, pg8::StaticOrder, true, true>(L + RING_OFF, g, S, E, wave); }
                { pg8::Gemm g{(const bf16*)(ws + WS_AR) + (size_t)MP * 3072, (const bf16*)(wt + WT_W67), MS, 2048, 256, 3072, 3072}; pg8::SplitOrder S; S.init(2048, 4, 256, G, bx); pg8::EpiSlab E{(float*)(ws + WS_SLAB), 0, 256};
                  pg8::gemm_phase<pg8::EpiSlab, pg8::SplitOrder, true, true>(L + RING_OFF, g, S, E, wave); }
                { pg8::Gemm g{(const bf16*)(ws + WS_AR) + (size_t)MP * 3072 + 1024, (const bf16*)(wt + WT_W67) + 1024, MS, 2048, 256, 3072, 3072}; pg8::SplitOrder S; S.init(2048, 8, 256, G, (bx + G - 32 % G) % G); pg8::EpiSlab E{(float*)(ws + WS_SLAB), 4, 256};
                  pg8::gemm_phase<pg8::EpiSlab, pg8::SplitOrder, true, true>(L + RING_OFF, g, S, E, wave); }
                SEAM();
            }
            if (IN(PH_MRF)) { finalize_gate(ws, gw, NGW); SEAM(); }
            if (IN(PH_OUT)) {
                { pg8::Gemm g{(const bf16*)(ws + WS_GM), (const bf16*)(wt + WT_WOUT), MP, 2048, 2048, 2048, 2048}; pg8::StaticOrder S; S.init(MP, 2048, G, bx); pg8::EpiRes E{ws, 1.0f};
                  pg8::gemm_phase<pg8::EpiRes, pg8::StaticOrder, true, true>(L + RING_OFF, g, S, E, wave); }
                { pg8::Gemm g{(const bf16*)(ws + WS_GM) + (size_t)MP * 2048, (const bf16*)(wt + WT_WOUT), MS, 2048, 256, 2048, 2048}; pg8::SplitOrder S; S.init(2048, 8, 256, G, bx); pg8::EpiSlab E{(float*)(ws + WS_SLAB), 0, 256};
                  pg8::gemm_phase<pg8::EpiSlab, pg8::SplitOrder, true, true>(L + RING_OFF, g, S, E, wave); }
                SEAM();
            }
            if (IN(PH_OUTF)) { finalize_res<8>(ws, 1.0f, gw, NGW); SEAM(); }
            }
        }
    }
    if (a.do_final) {
        const int lane = fresh_lane();
        const float* fg = a.in[21]; const bf16* XB = (const bf16*)(ws + WS_XB); const float* SS = (const float*)(ws + WS_SS);
        f32x4 fgv[8];
#pragma unroll
        for (int j = 0; j < 8; ++j) fgv[j] = *(const f32x4*)(fg + 256 * j + 4 * lane);
        for (int m = gw; m < MT; m += NGW) { const float sl = lane < 32 ? SS[(size_t)m * 32 + lane] : 0.f; uint2 xr[8];
#pragma unroll
            for (int j = 0; j < 8; ++j) xr[j] = *(const uint2*)(XB + (size_t)m * 2048 + 256 * j + 4 * lane);
            const float rstd = rsqrtf(wave_sum(sl) * (1.f / 2048.f) + NORM_EPS);
#pragma unroll
            for (int j = 0; j < 8; ++j) { const uint2 xb = xr[j];
                const f32x4 x = {__uint_as_float(xb.x << 16), __uint_as_float(xb.x & 0xffff0000u), __uint_as_float(xb.y << 16), __uint_as_float(xb.y & 0xffff0000u)};
                *(f32x4*)(a.out + OFF_Y + (size_t)m * 2048 + 256 * j + 4 * lane) = x * rstd * fgv[j]; } }
    }
#undef SEAM
#undef IN
}
}

static_assert(mk::WT_BYTES == WT_BYTES_TOTAL, "weight region size");
static int g_grid = 0;
extern "C" void kernel_launch(void* const* d_in, const int* in_sizes, int n_in, void* d_out, int out_size, void* d_ws, size_t ws_size, hipStream_t stream) {
    if (n_in != 22 || (size_t)out_size != OUT_TOTAL || ws_size < WS_END) { fprintf(stderr, "kernel_launch: unexpected shapes (n_in %d out %d ws %zu need %zu)\n", n_in, out_size, ws_size, (size_t)WS_END); return; }
    if (g_grid == 0) {
        int dev = 0, cus = 0;
        if (hipGetDevice(&dev) != hipSuccess || hipDeviceGetAttribute(&cus, hipDeviceAttributeMultiprocessorCount, dev) != hipSuccess) { g_grid = -1; return; }
        if (hipFuncSetAttribute((const void*)mk::mk_fwd, hipFuncAttributeMaxDynamicSharedMemorySize, mk::LDS_BYTES) != hipSuccess) { fprintf(stderr, "kernel_launch: hipFuncSetAttribute failed\n"); g_grid = -1; return; }
        int per_cu = 0; (void)hipOccupancyMaxActiveBlocksPerMultiprocessor(&per_cu, (const void*)mk::mk_fwd, mk::NWAVES * 64, mk::LDS_BYTES); (void)hipGetLastError();
        g_grid = cus;
    }
    if (g_grid < 0) return;
    (void)hipMemsetAsync((char*)d_ws + WS_CTL, 0, 1u << 20, stream);
    mk::Args a{}; for (int i = 0; i < 22; ++i) a.in[i] = (const float*)d_in[i]; a.out = (float*)d_out; a.ws = (unsigned char*)d_ws;
    a.l_lo = 0; a.l_hi = DEPTH; a.ph_lo = 0; a.ph_hi = mk::PH_PER_LAYER; a.fused = 1; a.do_final = 1;
    hipLaunchKernelGGL(mk::mk_fwd, dim3(g_grid), dim3(mk::NWAVES * 64), mk::LDS_BYTES, stream, a);
}
```

```cpp
#include <hip/hip_runtime.h>
#include <cstdio>
#include <cstdint>

constexpr int D_MODEL = 2048, BATCH = 4, SEQ = 4096, DEPTH = 2, DEC_BATCH = 16, DEC_SEQ = 16, PAST_LEN = 2048;
constexpr int D_FF = 5632, IN_WIDTH = 11328;
constexpr float NORM_EPS = 1e-6f, GN_EPS = 1e-5f;
constexpr int MP = BATCH * SEQ;
constexpr int MS = DEC_BATCH * DEC_SEQ;
constexpr int MT = MP + MS;
constexpr float QSCALE = 0.07216878364870322f * 1.4426950408889634f;
constexpr float RET_K_SCALE = 0.08838834764831845f;
constexpr int CO_QL = 0, CO_C = 512, CO_KR = 1024, CO_RQ = 1088, CO_RK = 2112, CO_RV = 3136, CO_RG = 5184, CO_GM = 7232, CO_GR = 9280;
constexpr size_t OFF_Y = 0, OFF_CKVP = (size_t)MT * D_MODEL, OFF_KRP = OFF_CKVP + (size_t)DEPTH * MP * 512, OFF_RETP = OFF_KRP + (size_t)DEPTH * MP * 64,
                 OFF_CKVS = OFF_RETP + (size_t)DEPTH * BATCH * 8 * 128 * 256, OFF_KRS = OFF_CKVS + (size_t)DEPTH * MS * 512, OFF_RETS = OFF_KRS + (size_t)DEPTH * MS * 64,
                 OUT_TOTAL = OFF_RETS + (size_t)DEPTH * DEC_BATCH * 8 * 128 * 256;
static_assert(OUT_TOTAL == 63733760, "output size");

typedef unsigned short bf16;
__host__ __device__ __forceinline__ float bf2f(bf16 b) { union { unsigned u; float f; } x; x.u = ((unsigned)b) << 16; return x.f; }
__host__ __device__ __forceinline__ bf16 f2bf(float f) { union { unsigned u; float f; } x; x.f = f; unsigned u = x.u; u += 0x7fffu + ((u >> 16) & 1u); return (bf16)(u >> 16); }
__device__ __forceinline__ int row_pos(int r) { return r < MP ? (r % SEQ) : (PAST_LEN + ((r - MP) % DEC_SEQ)); }
__device__ __forceinline__ int fresh_lane() { int z = 0; asm volatile("" : "+v"(z)); return __builtin_amdgcn_mbcnt_hi(~0u, __builtin_amdgcn_mbcnt_lo(~0u, z)); }
__device__ __forceinline__ float silu_f(float v) { return v / (1.f + __expf(-v)); }
__device__ __forceinline__ float sigmoid_f(float v) { return 1.f / (1.f + __expf(-v)); }

constexpr size_t al256(size_t x) { return (x + 255) & ~(size_t)255; }
constexpr size_t WS_CTL = 0;
constexpr size_t WS_ROPE64 = 1u << 20;
constexpr size_t WS_ROPE128 = WS_ROPE64 + (size_t)4096 * 32 * 8;
constexpr size_t WS_SS = al256(WS_ROPE128 + (size_t)4096 * 64 * 8);
constexpr size_t WS_SQ = WS_SS + (size_t)MT * 32 * 4;
constexpr size_t WS_SC = WS_SQ + (size_t)MT * 8 * 4;
constexpr size_t WS_XB = al256(WS_SC + (size_t)MT * 8 * 4);
constexpr size_t WS_Q = WS_XB + (size_t)MT * 2048 * 2;
constexpr size_t WS_KN = WS_Q + (size_t)MT * 1536 * 2;
constexpr size_t WS_VV = WS_KN + (size_t)MP * 1024 * 2;
constexpr size_t WS_AR = WS_VV + (size_t)MP * 1024 * 2;
constexpr size_t WS_PROJ = WS_AR + (size_t)MT * 3072 * 2;
constexpr size_t WS_HB = WS_PROJ;
constexpr size_t WS_QL = WS_PROJ;
constexpr size_t WS_CRB = WS_QL + (size_t)MT * 512 * 2;
constexpr size_t WS_KR = WS_CRB + (size_t)MT * 512 * 2;
constexpr size_t WS_RQ = WS_KR + (size_t)MT * 64 * 2;
constexpr size_t WS_RK = WS_RQ + (size_t)MT * 1024 * 2;
constexpr size_t WS_RV = WS_RK + (size_t)MT * 1024 * 2;
constexpr size_t WS_RG = WS_RV + (size_t)MT * 2048 * 2;
constexpr size_t WS_GM = WS_RG + (size_t)MT * 2048 * 2;
constexpr size_t WS_GR = WS_GM + (size_t)MT * 2048 * 2;
constexpr size_t WS_PROJ_END = WS_GR + (size_t)MT * 2048 * 2;
static_assert(WS_HB + (size_t)MT * 5632 * 2 <= WS_PROJ_END, "HB overlay fits");
static_assert(WS_RK == WS_RQ + (size_t)MT * 1024 * 2 && WS_RG == WS_RV + (size_t)MT * 2048 * 2 && WS_GM == WS_RG + (size_t)MT * 2048 * 2 && WS_GR == WS_GM + (size_t)MT * 2048 * 2 && WS_VV == WS_KN + (size_t)MP * 1024 * 2 && WS_SC == WS_SQ + (size_t)MT * 8 * 4, "epilogues index these buffers as arrays");
constexpr size_t WS_WT = al256(WS_PROJ_END);
constexpr size_t WT_BYTES_TOTAL = 210239488;
constexpr size_t WS_CALL = al256(WS_WT + WT_BYTES_TOTAL);
constexpr size_t WS_SLAB = al256(WS_CALL + (size_t)DEC_BATCH * 2112 * 576 * 2);
constexpr size_t WS_END = WS_SLAB + (size_t)12 * MS * 2048 * 4;

namespace pg8 {
#define PG8_LAS __attribute__((address_space(3)))
typedef unsigned short bf16_t;
typedef short bf16x8 __attribute__((ext_vector_type(8)));
typedef float f32x4 __attribute__((ext_vector_type(4)));
typedef unsigned u32x4 __attribute__((ext_vector_type(4)));
constexpr int BM = 256, BK = 64, HALF = 128, HTB = HALF * BK * 2  , STAGE_BYTES = 8 * HTB, NXCD = 8, WGM = 4;

__host__ __device__ __forceinline__ int lds_byte(int r, int c) { const int st = (r >> 4) * 2 + (c >> 5), rr = r & 15, cc = c & 31, ob = rr * 64 + cc * 2; return st * 1024 + (ob ^ (((ob >> 9) & 1) << 5)); }
__host__ __device__ __forceinline__ void stage_rc(int b, int& R, int& C) { const int st = b / 1024, sb = b % 1024, swz = sb ^ (((sb >> 9) & 1) << 5); R = (st >> 1) * 16 + swz / 64; C = (st & 1) * 32 + (swz % 64) / 2; }
__host__ __device__ __forceinline__ int perm32(int rho) { const int n = rho >> 4, i = rho & 15; return 8 * (i >> 2) + 4 * n + (i & 3); }

struct Unit { int pm, pn, ko; };
struct Gemm { const bf16_t* A; const bf16_t* Bt; int M, N, K, lda, ldb; int kstepA = 0; size_t tstepA = 0; int kstepB = 0; size_t tstepB = 0; };

struct StaticOrder {
    int nM, nN, nwg, G, c;
    __host__ __device__ void init(int M, int N, int G_, int c_) { nM = M / BM; nN = N / BM; nwg = nM * nN; G = G_; c = c_; }
    __host__ __device__ bool next(int i, Unit& u) const {
        const long L = (long)i * G + c; if (L >= nwg) return false;
        int wgid = (int)L; { const int q = nwg / NXCD, r = nwg % NXCD, xcd = wgid % NXCD, off = wgid / NXCD; wgid = (xcd < r ? xcd * (q + 1) : r * (q + 1) + (xcd - r) * q) + off; }
        const int nig = WGM * nN, gid = wgid / nig, fm = gid * WGM, gsz = (nM - fm) < WGM ? (nM - fm) : WGM;
        u.pm = fm + ((wgid % nig) % gsz); u.pn = (wgid % nig) / gsz; u.ko = 0; return true;
    }
    __device__ __forceinline__ void a_ready(const Unit&) const {}
    __device__ __forceinline__ void done(const Unit&) const {}
};

struct SplitOrder {
    int nN, nS, ksl, G, c;
    __host__ __device__ void init(int N, int nslices, int ksl_, int G_, int c_) { nN = N / BM; nS = nslices; ksl = ksl_; G = G_; c = c_; }
    __device__ __forceinline__ bool next(int i, Unit& u) const { const int L = i * G + c; if (L >= nN * nS) return false; u.pm = 0; u.pn = L % nN; u.ko = (L / nN) * ksl; return true; }
    __device__ __forceinline__ void a_ready(const Unit&) const {}
    __device__ __forceinline__ void done(const Unit&) const {}
};

__device__ __forceinline__ unsigned cvt_pk_bf16(float lo, float hi) { unsigned r; asm volatile("v_cvt_pk_bf16_f32 %0, %1, %2" : "=v"(r) : "v"(lo), "v"(hi)); return r; }
typedef float f32x2 __attribute__((ext_vector_type(2)));
typedef unsigned u32x2 __attribute__((ext_vector_type(2)));
__device__ __forceinline__ u32x4 pack8(const f32x4& a, const f32x4& b) { u32x4 w; w.x = cvt_pk_bf16(a[0], a[1]); w.y = cvt_pk_bf16(a[2], a[3]); w.z = cvt_pk_bf16(b[0], b[1]); w.w = cvt_pk_bf16(b[2], b[3]); return w; }
__device__ __forceinline__ u32x2 pack4(const f32x4& a) { u32x2 w; w.x = cvt_pk_bf16(a[0], a[1]); w.y = cvt_pk_bf16(a[2], a[3]); return w; }
__device__ __forceinline__ void unpack8(const u32x4& w, f32x4& a, f32x4& b) {
    a[0] = __uint_as_float(w.x << 16); a[1] = __uint_as_float(w.x & 0xffff0000u); a[2] = __uint_as_float(w.y << 16); a[3] = __uint_as_float(w.y & 0xffff0000u);
    b[0] = __uint_as_float(w.z << 16); b[1] = __uint_as_float(w.z & 0xffff0000u); b[2] = __uint_as_float(w.w << 16); b[3] = __uint_as_float(w.w & 0xffff0000u); }
__device__ __forceinline__ float fsilu(float v) { return v * __builtin_amdgcn_rcpf(1.f + __expf(-v)); }
__device__ __forceinline__ float fsigm(float v) { return __builtin_amdgcn_rcpf(1.f + __expf(-v)); }
__device__ __forceinline__ float dot4(const f32x4& a) { return (a[0] * a[0] + a[1] * a[1]) + (a[2] * a[2] + a[3] * a[3]); }
template <int NS> __device__ __forceinline__ void load_rstd(const float* S, int rowbase, int fq, float invn, float (&rs)[2][4]) {
#pragma unroll
    for (int ai = 0; ai < 2; ++ai)
#pragma unroll
        for (int m = 0; m < 4; ++m) {
            const float* p = S + (size_t)(rowbase + ai * HALF + m * 16) * NS + fq * (NS / 4); float s;
            if constexpr (NS == 32) { const f32x4 a = *(const f32x4*)p, b = *(const f32x4*)(p + 4); s = ((a[0] + a[1]) + (a[2] + a[3])) + ((b[0] + b[1]) + (b[2] + b[3])); }
            else { const f32x2 a = *(const f32x2*)p; s = a[0] + a[1]; }
            s += __shfl_xor(s, 16); s += __shfl_xor(s, 32);
            rs[ai][m] = rsqrtf(s * invn + NORM_EPS);
        }
}
#define PG8_LAS_F __attribute__((address_space(3)))
template <int NS> __device__ __forceinline__ void fill_rstd_panel(const float* S, int pm, float invn, PG8_LAS_F float* rsl, int tid) {
    const int row = tid >> 1, hf = tid & 1; const float* p = S + ((size_t)pm * BM + row) * NS + hf * (NS / 2); float s;
    if constexpr (NS == 32) { const f32x4 a = *(const f32x4*)p, b = *(const f32x4*)(p + 4), c = *(const f32x4*)(p + 8), d = *(const f32x4*)(p + 12);
        s = (((a[0] + a[1]) + (a[2] + a[3])) + ((b[0] + b[1]) + (b[2] + b[3]))) + (((c[0] + c[1]) + (c[2] + c[3])) + ((d[0] + d[1]) + (d[2] + d[3]))); }
    else { const f32x4 a = *(const f32x4*)p; s = (a[0] + a[1]) + (a[2] + a[3]); }
    s += __shfl_xor(s, 1);
    if (hf == 0) rsl[row] = rsqrtf(s * invn + NORM_EPS);
}
__device__ __forceinline__ void read_rstd(const PG8_LAS_F float* rsl, int wr, int fr, float (&rs)[2][4]) {
#pragma unroll
    for (int ai = 0; ai < 2; ++ai)
#pragma unroll
        for (int m = 0; m < 4; ++m) rs[ai][m] = rsl[wr * 64 + fr + ai * HALF + m * 16];
}
__device__ __forceinline__ void rope8(const f32x4* cs, const f32x4& x1lo, const f32x4& x1hi, const f32x4& x2lo, const f32x4& x2hi, f32x4& y1lo, f32x4& y1hi, f32x4& y2lo, f32x4& y2hi) {
    const f32x4 c0 = cs[0], c1 = cs[1], c2 = cs[2], c3 = cs[3];
    const f32x4 coslo = {c0[0], c0[2], c1[0], c1[2]}, sinlo = {c0[1], c0[3], c1[1], c1[3]}, coshi = {c2[0], c2[2], c3[0], c3[2]}, sinhi = {c2[1], c2[3], c3[1], c3[3]};
    y1lo = x1lo * coslo - x2lo * sinlo; y2lo = x2lo * coslo + x1lo * sinlo; y1hi = x1hi * coshi - x2hi * sinhi; y2hi = x2hi * coshi + x1hi * sinhi;
}

struct EpiUp {
    static constexpr bool PERM = false, AFTER_DRAIN = false; static constexpr int RS_NS = 32; static constexpr float RS_INVN = 1.f / 2048.f; __device__ __forceinline__ const float* rs_src() const { return (const float*)(ws + WS_SS); }

    unsigned char* ws;
    __device__ __forceinline__ void operator()(const f32x4 (&acc)[2][2][4][2], const Unit& u, int wr, int wc, int fr, int fq, const PG8_LAS_F float* rsl) const {
        bf16_t* HB = (bf16_t*)(ws + WS_HB);
        const int rowbase = u.pm * BM + wr * 64 + fr; float rs[2][4]; read_rstd(rsl, wr, fr, rs);
        const int col = u.pn * 128 + wc * 32 + fq * 8;
#pragma unroll
        for (int ai = 0; ai < 2; ++ai)
#pragma unroll
            for (int m = 0; m < 4; ++m) { const float r = rs[ai][m], rl = r * -1.44269504f, r2 = r * r; f32x4 hh[2];
#pragma unroll
                for (int n = 0; n < 2; ++n) { const f32x4 a = acc[ai][0][m][n], t = a * rl; f32x4 d;
#pragma unroll
                    for (int e = 0; e < 4; ++e) d[e] = __builtin_amdgcn_exp2f(t[e]);
                    d = d + 1.f;
#pragma unroll
                    for (int e = 0; e < 4; ++e) d[e] = __builtin_amdgcn_rcpf(d[e]);
                    hh[n] = ((a * acc[ai][1][m][n]) * d) * r2; }
                const f32x4 h0 = hh[0], h1 = hh[1];
                *(u32x4*)(HB + ((size_t)(u.pm * (D_FF / 64) + (col >> 6)) * BM + (wr * 64 + fr + ai * HALF + m * 16)) * 64 + (col & 63)) = pack8(h0, h1); }
    }
};
struct EpiRes {
    static constexpr bool PERM = false, AFTER_DRAIN = false; static constexpr int RS_NS = 0;
    unsigned char* ws; float scale;
    __device__ __forceinline__ void operator()(const f32x4 (&acc)[2][2][4][2], const Unit& u, int wr, int wc, int fr, int fq) const {
        bf16_t* XB = (bf16_t*)(ws + WS_XB); float* SS = (float*)(ws + WS_SS);
        const int rowbase = u.pm * BM + wr * 64 + fr;
        u32x4 xr[2][4][2];
#pragma unroll
        for (int ai = 0; ai < 2; ++ai)
#pragma unroll
            for (int m = 0; m < 4; ++m)
#pragma unroll
                for (int bj = 0; bj < 2; ++bj) xr[ai][m][bj] = *(const u32x4*)(XB + (size_t)(rowbase + ai * HALF + m * 16) * 2048 + u.pn * BM + bj * HALF + wc * 32 + fq * 8);
#pragma unroll
        for (int ai = 0; ai < 2; ++ai)
#pragma unroll
            for (int m = 0; m < 4; ++m) { const int row = rowbase + ai * HALF + m * 16; float ssq = 0.f;
#pragma unroll
                for (int bj = 0; bj < 2; ++bj) { const size_t idx = (size_t)row * 2048 + u.pn * BM + bj * HALF + wc * 32 + fq * 8;
                    f32x4 x0, x1; unpack8(xr[ai][m][bj], x0, x1); x0 += acc[ai][bj][m][0] * scale; x1 += acc[ai][bj][m][1] * scale;
                    *(u32x4*)(XB + idx) = pack8(x0, x1); ssq += dot4(x0) + dot4(x1); }
                ssq += __shfl_xor(ssq, 16); ssq += __shfl_xor(ssq, 32);
                if (fq == 0) SS[(size_t)row * 32 + u.pn * 4 + wc] = ssq; }
    }
};
struct EpiWin {
    static constexpr bool PERM = false, AFTER_DRAIN = false; static constexpr int RS_NS = 32; static constexpr float RS_INVN = 1.f / 2048.f; __device__ __forceinline__ const float* rs_src() const { return (const float*)(ws + WS_SS); }

    unsigned char* ws; float* out; int layer;
    __device__ __forceinline__ void operator()(const f32x4 (&acc)[2][2][4][2], const Unit& u, int wr, int wc, int fr, int fq, const PG8_LAS_F float* rsl) const {
        bf16_t *QL = (bf16_t*)(ws + WS_QL), *CRB = (bf16_t*)(ws + WS_CRB), *KR = (bf16_t*)(ws + WS_KR);
        const float2 *t64 = (const float2*)(ws + WS_ROPE64), *t128 = (const float2*)(ws + WS_ROPE128);
        const int rowbase = u.pm * BM + wr * 64 + fr; float rs[2][4]; read_rstd(rsl, wr, fr, rs);
        const int t = u.pn;
        if (t < 4) {
#pragma unroll
            for (int ai = 0; ai < 2; ++ai)
#pragma unroll
                for (int m = 0; m < 4; ++m) { const int row = rowbase + ai * HALF + m * 16; const float r = rs[ai][m]; float ssq = 0.f;
#pragma unroll
                    for (int bj = 0; bj < 2; ++bj) { const f32x4 v0 = acc[ai][bj][m][0] * r, v1 = acc[ai][bj][m][1] * r; const size_t idx = (size_t)row * 512 + (t & 1) * 256 + bj * HALF + wc * 32 + fq * 8;
                        if (t < 2) *(u32x4*)(QL + idx) = pack8(v0, v1);
                        else *(u32x4*)(CRB + idx) = pack8(v0, v1);
                        ssq += dot4(v0) + dot4(v1); }
                    ssq += __shfl_xor(ssq, 16); ssq += __shfl_xor(ssq, 32);
                    if (fq == 0) ((float*)(ws + WS_SQ) + (t >> 1) * (size_t)MT * 8)[(size_t)row * 8 + (t & 1) * 4 + wc] = ssq; }
        } else if (t < 12) {
            bf16_t* dst = (bf16_t*)(ws + WS_RQ) + (t >> 3) * (size_t)MT * 1024; const float ks = t < 8 ? 1.f : RET_K_SCALE; const int head = 2 * ((t - 4) & 3) + (wc >> 1), idx0 = 32 * (wc & 1) + 8 * fq;
#pragma unroll
            for (int ai = 0; ai < 2; ++ai) { f32x4 csv[2][4];
#pragma unroll
                for (int mh = 0; mh < 2; ++mh) {
#pragma unroll
                for (int mm = 0; mm < 2; ++mm) { const f32x4* cp = (const f32x4*)(t128 + (size_t)row_pos(rowbase + ai * HALF + (2 * mh + mm) * 16) * 64 + idx0); csv[mm][0] = cp[0]; csv[mm][1] = cp[1]; csv[mm][2] = cp[2]; csv[mm][3] = cp[3]; }
#pragma unroll
                for (int mm = 0; mm < 2; ++mm) { const int m = 2 * mh + mm; const int row = rowbase + ai * HALF + m * 16; const float r = rs[ai][m] * ks; const f32x4* cs = csv[mm];
                    f32x4 y1lo, y1hi, y2lo, y2hi; rope8(cs, acc[ai][0][m][0] * r, acc[ai][1][m][0] * r, acc[ai][0][m][1] * r, acc[ai][1][m][1] * r, y1lo, y1hi, y2lo, y2hi);
                    bf16_t* d = dst + (size_t)row * 1024 + head * 128 + idx0; *(u32x4*)d = pack8(y1lo, y1hi); *(u32x4*)(d + 64) = pack8(y2lo, y2hi); } } }
        } else if (t < 44) {
            const int kind = (t - 12) >> 3, tt = (t - 12) & 7; bf16_t* dst = (bf16_t*)(ws + WS_RV) + kind * (size_t)MT * 2048;
#pragma unroll
            for (int ai = 0; ai < 2; ++ai)
#pragma unroll
                for (int m = 0; m < 4; ++m) { const int row = rowbase + ai * HALF + m * 16; const float r = rs[ai][m];
#pragma unroll
                    for (int bj = 0; bj < 2; ++bj) { f32x4 v0 = acc[ai][bj][m][0] * r, v1 = acc[ai][bj][m][1] * r;
                        if (kind == 1) {
#pragma unroll
                            for (int e = 0; e < 4; ++e) { v0[e] = fsilu(v0[e]); v1[e] = fsilu(v1[e]); } }
                        else if (kind >= 2) {
#pragma unroll
                            for (int e = 0; e < 4; ++e) { v0[e] = fsigm(v0[e]); v1[e] = fsigm(v1[e]); } }
                        *(u32x4*)(dst + (size_t)row * 2048 + tt * 256 + bj * HALF + wc * 32 + fq * 8) = pack8(v0, v1); } }
        } else {
            if (wc < 2) { const int idx0 = 16 * wc + 4 * fq;
#pragma unroll
                for (int ai = 0; ai < 2; ++ai) { f32x4 ct[4][2];
#pragma unroll
                    for (int m = 0; m < 4; ++m) { const f32x4* cs = (const f32x4*)(t64 + (size_t)row_pos(rowbase + ai * HALF + m * 16) * 32 + idx0); ct[m][0] = cs[0]; ct[m][1] = cs[1]; }
#pragma unroll
                    for (int m = 0; m < 4; ++m) { const int row = rowbase + ai * HALF + m * 16; const float r = rs[ai][m];
                        const f32x4 c0 = ct[m][0], c1 = ct[m][1], co = {c0[0], c0[2], c1[0], c1[2]}, si = {c0[1], c0[3], c1[1], c1[3]}, x1 = acc[ai][0][m][0] * r, x2 = acc[ai][0][m][1] * r;
                        const f32x4 y1 = x1 * co - x2 * si, y2 = x2 * co + x1 * si;
                        float* ko = row < MP ? out + OFF_KRP + ((size_t)layer * MP + row) * 64 : out + OFF_KRS + ((size_t)layer * MS + (row - MP)) * 64;
                        *(f32x4*)(ko + idx0) = y1; *(f32x4*)(ko + 32 + idx0) = y2; *(u32x2*)(KR + (size_t)row * 64 + idx0) = pack4(y1); *(u32x2*)(KR + (size_t)row * 64 + 32 + idx0) = pack4(y2); } } }
        }
    }
};
struct EpiQ {
    static constexpr bool PERM = false, AFTER_DRAIN = false; static constexpr int RS_NS = 8; static constexpr float RS_INVN = 1.f / 512.f; __device__ __forceinline__ const float* rs_src() const { return (const float*)(ws + WS_SQ); }

    unsigned char* ws;
    __device__ __forceinline__ void operator()(const f32x4 (&acc)[2][2][4][2], const Unit& u, int wr, int wc, int fr, int fq, const PG8_LAS_F float* rsl) const {
        bf16_t* Q = (bf16_t*)(ws + WS_Q); const float2* t64 = (const float2*)(ws + WS_ROPE64);
        const int rowbase = u.pm * BM + wr * 64 + fr; float rs[2][4]; read_rstd(rsl, wr, fr, rs);
        const int t = u.pn;
        if (t < 4) {
#pragma unroll
            for (int ai = 0; ai < 2; ++ai)
#pragma unroll
                for (int m = 0; m < 4; ++m) { const int row = rowbase + ai * HALF + m * 16; const float r = rs[ai][m] * QSCALE;
#pragma unroll
                    for (int bj = 0; bj < 2; ++bj) *(u32x4*)(Q + (size_t)row * 1536 + (2 * t + bj) * 192 + wc * 32 + fq * 8) = pack8(acc[ai][bj][m][0] * r, acc[ai][bj][m][1] * r); }
        } else { const int head = 4 * (t - 4) + wc, idx0 = 8 * fq;
#pragma unroll
            for (int ai = 0; ai < 2; ++ai) { f32x4 csv[2][4];
#pragma unroll
                for (int mh = 0; mh < 2; ++mh) {
#pragma unroll
                for (int mm = 0; mm < 2; ++mm) { const f32x4* cp = (const f32x4*)(t64 + (size_t)row_pos(rowbase + ai * HALF + (2 * mh + mm) * 16) * 32 + idx0); csv[mm][0] = cp[0]; csv[mm][1] = cp[1]; csv[mm][2] = cp[2]; csv[mm][3] = cp[3]; }
#pragma unroll
                for (int mm = 0; mm < 2; ++mm) { const int m = 2 * mh + mm; const int row = rowbase + ai * HALF + m * 16; const float r = rs[ai][m] * QSCALE; const f32x4* cs = csv[mm];
                    f32x4 y1lo, y1hi, y2lo, y2hi; rope8(cs, acc[ai][0][m][0] * r, acc[ai][1][m][0] * r, acc[ai][0][m][1] * r, acc[ai][1][m][1] * r, y1lo, y1hi, y2lo, y2hi);
                    bf16_t* d = Q + (size_t)row * 1536 + head * 192 + 128 + idx0; *(u32x4*)d = pack8(y1lo, y1hi); *(u32x4*)(d + 32) = pack8(y2lo, y2hi); } } }
        }
    }
};
struct EpiKV {
    static constexpr bool PERM = false, AFTER_DRAIN = false; static constexpr int RS_NS = 8; static constexpr float RS_INVN = 1.f / 512.f; __device__ __forceinline__ const float* rs_src() const { return (const float*)(ws + WS_SC); }

    unsigned char* ws;
    __device__ __forceinline__ void operator()(const f32x4 (&acc)[2][2][4][2], const Unit& u, int wr, int wc, int fr, int fq, const PG8_LAS_F float* rsl) const {
        const int rowbase = u.pm * BM + wr * 64 + fr; float rs[2][4]; read_rstd(rsl, wr, fr, rs);
        bf16_t* dst = (bf16_t*)(ws + WS_KN) + (u.pn >> 2) * (size_t)MP * 1024 + (u.pn & 3) * 256 + wc * 32 + fq * 8;
#pragma unroll
        for (int ai = 0; ai < 2; ++ai)
#pragma unroll
            for (int m = 0; m < 4; ++m) { const int row = rowbase + ai * HALF + m * 16; const float r = rs[ai][m];
#pragma unroll
                for (int bj = 0; bj < 2; ++bj) *(u32x4*)(dst + (size_t)row * 1024 + bj * HALF) = pack8(acc[ai][bj][m][0] * r, acc[ai][bj][m][1] * r); }
    }
};
template <int MODE> struct EpiGate {
    static constexpr bool PERM = false, AFTER_DRAIN = false; static constexpr int RS_NS = 0;
    unsigned char* ws;
    __device__ __forceinline__ void operator()(const f32x4 (&acc)[2][2][4][2], const Unit& u, int wr, int wc, int fr, int fq) const {
        bf16_t* GM = (bf16_t*)(ws + WS_GM); const bf16_t* GR = (const bf16_t*)(ws + WS_GR);
        const int rowbase = u.pm * BM + wr * 64 + fr;
#pragma unroll
        for (int ai = 0; ai < 2; ++ai) { u32x4 gm[4][2], gr[4][2];
#pragma unroll
            for (int m = 0; m < 4; ++m)
#pragma unroll
                for (int bj = 0; bj < 2; ++bj) { const size_t idx = (size_t)(rowbase + ai * HALF + m * 16) * 2048 + u.pn * BM + bj * HALF + wc * 32 + fq * 8; gm[m][bj] = *(const u32x4*)(GM + idx); if (MODE == 1) gr[m][bj] = *(const u32x4*)(GR + idx); }
#pragma unroll
            for (int m = 0; m < 4; ++m)
#pragma unroll
                for (int bj = 0; bj < 2; ++bj) { const size_t idx = (size_t)(rowbase + ai * HALF + m * 16) * 2048 + u.pn * BM + bj * HALF + wc * 32 + fq * 8; f32x4 g0, g1; unpack8(gm[m][bj], g0, g1);
                    if (MODE == 0) { g0 *= acc[ai][bj][m][0]; g1 *= acc[ai][bj][m][1]; }
                    else { f32x4 r0, r1; unpack8(gr[m][bj], r0, r1); g0 += r0 * acc[ai][bj][m][0]; g1 += r1 * acc[ai][bj][m][1]; }
                    *(u32x4*)(GM + idx) = pack8(g0, g1); } }
    }
};

struct EpiSlab {
    static constexpr bool PERM = false, AFTER_DRAIN = false; static constexpr int RS_NS = 0;
    float* slab; int slice0, ksl;
    __device__ __forceinline__ void operator()(const f32x4 (&acc)[2][2][4][2], const Unit& u, int wr, int wc, int fr, int fq) const {
        float* base = slab + ((size_t)(slice0 + u.ko / ksl) * BM + wr * 64 + fr) * 2048 + u.pn * BM + wc * 32 + fq * 8;
#pragma unroll
        for (int ai = 0; ai < 2; ++ai)
#pragma unroll
            for (int m = 0; m < 4; ++m)
#pragma unroll
                for (int bj = 0; bj < 2; ++bj) { float* p = base + (size_t)(ai * HALF + m * 16) * 2048 + bj * HALF; *(f32x4*)p = acc[ai][bj][m][0]; *(f32x4*)(p + 4) = acc[ai][bj][m][1]; }
    }
};

template <class Epi, class Sched, bool ALIGN_EPI = false, bool SP2 = false>
__device__ __forceinline__ void gemm_phase(PG8_LAS unsigned char* lds, const Gemm g_in, const Sched& S, const Epi& E, int wave_id) {
    Gemm g = g_in; { const bf16_t* pa = g.A; const bf16_t* pb = g.Bt; asm volatile("" : "+s"(pa), "+s"(pb)); g.A = pa; g.Bt = pb; }
    const int wid = wave_id, lane = fresh_lane(), tid = wid * 64 + lane,
              wr = wid >> 2, wc = wid & 3, fr = lane & 15, fq = lane >> 4;
    const int K = g.K, nt = K / BK;
    unsigned voffA[2], voffB[2];
#pragma unroll
    for (int i = 0; i < 2; ++i) { int R, C; stage_rc(tid * 16 + i * 8192, R, C); const int Rb = Epi::PERM ? ((R & ~31) + perm32(R & 31)) : R;
        voffA[i] = (unsigned)(R * g.lda + C) * 2u; voffB[i] = (unsigned)(Rb * g.ldb + C) * 2u; }
    const size_t kstepB = g.kstepB ? (size_t)g.kstepB : (size_t)(BK * 2), kstepA = g.kstepA ? (size_t)g.kstepA : (size_t)(BK * 2);
    const size_t hstepA = (size_t)HALF * g.lda * 2, hstepB = (size_t)HALF * g.ldb * 2;
    const size_t tstepA = g.tstepA ? g.tstepA : 2 * hstepA, tstepB = g.tstepB ? g.tstepB : 2 * hstepB;
    const unsigned ldsw = (unsigned)wid * 1024u;
    const int aoff = lds_byte(wr * 64 + fr, fq * 8), boff = lds_byte(wc * 32 + fr, fq * 8);
#define PG8_SA(b, h) (((b) * 2 + (h)) * HTB)
#define PG8_SB(b, h) ((4 + (b) * 2 + (h)) * HTB)
#define PG8_STAGE(bufoff, gbase, voff) do { _Pragma("unroll") for (int _i = 0; _i < 2; ++_i) \
        __builtin_amdgcn_global_load_lds((const unsigned*)((const char*)(gbase) + (voff)[_i]), (PG8_LAS unsigned*)(lds + (bufoff) + ldsw + _i * 8192), 16, 0, 0); } while (0)
#define PG8_LDA(dst, b, h) do { _Pragma("unroll") for (int m = 0; m < 4; ++m) _Pragma("unroll") for (int k = 0; k < 2; ++k) dst[m][k] = *(const PG8_LAS bf16x8*)(lds + PG8_SA(b, h) + aoff + m * 2048 + k * 1024); } while (0)
#define PG8_LDB(dst, b, h) do { _Pragma("unroll") for (int n = 0; n < 2; ++n) _Pragma("unroll") for (int k = 0; k < 2; ++k) dst[n][k] = *(const PG8_LAS bf16x8*)(lds + PG8_SB(b, h) + boff + n * 2048 + k * 1024); } while (0)
#define PG8_MMA(ai, bj, At, Bt) do { __builtin_amdgcn_s_setprio(1); _Pragma("unroll") for (int m = 0; m < 4; ++m) _Pragma("unroll") for (int n = 0; n < 2; ++n) _Pragma("unroll") for (int k = 0; k < 2; ++k) \
        acc[ai][bj][m][n] = __builtin_amdgcn_mfma_f32_16x16x32_bf16(Bt[n][k], At[m][k], acc[ai][bj][m][n], 0, 0, 0); __builtin_amdgcn_s_setprio(0); } while (0)
#define PG8_WAIT_V(n) asm volatile("s_waitcnt vmcnt(" #n ")" ::: "memory")
#define PG8_WAIT_L(n) asm volatile("s_waitcnt lgkmcnt(" #n ")" ::: "memory")
#define PG8_BAR __builtin_amdgcn_s_barrier()
#define PG8_SCHED __builtin_amdgcn_sched_barrier(0)
    Unit cur, nxt; int ui = 0, rs_pm = -1;
    if (!S.next(0, cur)) return;
    f32x4 acc[2][2][4][2];
#pragma unroll
    for (int a = 0; a < 2; ++a)
#pragma unroll
        for (int b = 0; b < 2; ++b)
#pragma unroll
            for (int m = 0; m < 4; ++m)
#pragma unroll
                for (int n = 0; n < 2; ++n) acc[a][b][m][n] = (f32x4){0.f, 0.f, 0.f, 0.f};
    bf16x8 At[4][2], B0[2][2], B1[2][2];
    const char* cA = (const char*)g.A + (size_t)cur.pm * tstepA + (size_t)(cur.ko / BK) * kstepA; const char* cB = (const char*)g.Bt + (size_t)cur.pn * tstepB + (size_t)(cur.ko / BK) * kstepB;
    S.a_ready(cur);
    if constexpr (SP2) {
        PG8_STAGE(PG8_SB(0, 0), cB, voffB); PG8_STAGE(PG8_SB(0, 1), cB + hstepB, voffB); PG8_STAGE(PG8_SA(0, 0), cA, voffA); PG8_STAGE(PG8_SA(0, 1), cA + hstepA, voffA);
        if (wr == 1) PG8_BAR;
        PG8_WAIT_V(2); PG8_BAR;
        PG8_STAGE(PG8_SB(1, 0), cB + kstepB, voffB); PG8_STAGE(PG8_SA(1, 0), cA + kstepA, voffA); PG8_STAGE(PG8_SB(1, 1), cB + hstepB + kstepB, voffB);
        PG8_WAIT_V(6); PG8_BAR;
    } else {
        PG8_STAGE(PG8_SB(0, 0), cB, voffB); PG8_STAGE(PG8_SA(0, 0), cA, voffA); PG8_STAGE(PG8_SB(0, 1), cB + hstepB, voffB); PG8_STAGE(PG8_SA(0, 1), cA + hstepA, voffA);
        if (wr == 1) PG8_BAR;
        PG8_WAIT_V(4); PG8_BAR;
        PG8_STAGE(PG8_SB(1, 0), cB + kstepB, voffB); PG8_STAGE(PG8_SA(1, 0), cA + kstepA, voffA); PG8_STAGE(PG8_SB(1, 1), cB + hstepB + kstepB, voffB);
        PG8_WAIT_V(6); PG8_BAR;
    }
    for (;;) {
        const bool has_next = S.next(ui + 1, nxt);
        const char* nA = has_next ? (const char*)g.A + (size_t)nxt.pm * tstepA + (size_t)(nxt.ko / BK) * kstepA : cA; const char* nB = has_next ? (const char*)g.Bt + (size_t)nxt.pn * tstepB + (size_t)(nxt.ko / BK) * kstepB : cB;
        for (int t = 0; t < nt; t += 2) {
            const bool last = (t == nt - 2);
            const char* a1 = cA + (size_t)(t + 1) * kstepA;
            const char* a2 = last ? nA : cA + (size_t)(t + 2) * kstepA; const char* b2 = last ? nB : cB + (size_t)(t + 2) * kstepB;
            const char* a3 = a2 + kstepA; const char* b3 = b2 + kstepB;
            if (last && has_next) S.a_ready(nxt);
            if constexpr (SP2) {
            PG8_LDB(B0, 0, 0); PG8_LDB(B1, 0, 1); PG8_SCHED; PG8_LDA(At, 0, 0); PG8_STAGE(PG8_SA(1, 1), a1 + hstepA, voffA);
            PG8_WAIT_V(8); PG8_WAIT_L(0); PG8_BAR; PG8_MMA(0, 0, At, B0); PG8_MMA(0, 1, At, B1); PG8_BAR; PG8_SCHED;
            PG8_LDA(At, 0, 1); PG8_STAGE(PG8_SB(0, 0), b2, voffB); PG8_STAGE(PG8_SB(0, 1), b2 + hstepB, voffB); PG8_STAGE(PG8_SA(0, 0), a2, voffA);
            PG8_WAIT_V(8); PG8_WAIT_L(0); PG8_BAR; PG8_MMA(1, 0, At, B0); PG8_MMA(1, 1, At, B1); PG8_BAR; PG8_SCHED;
            PG8_LDB(B0, 1, 0); PG8_LDB(B1, 1, 1); PG8_SCHED; PG8_LDA(At, 1, 0); PG8_STAGE(PG8_SA(0, 1), a2 + hstepA, voffA);
            PG8_WAIT_V(8); PG8_WAIT_L(0); PG8_BAR; PG8_MMA(0, 0, At, B0); PG8_MMA(0, 1, At, B1); PG8_BAR; PG8_SCHED;
            PG8_LDA(At, 1, 1); PG8_STAGE(PG8_SB(1, 0), b3, voffB); PG8_STAGE(PG8_SB(1, 1), b3 + hstepB, voffB); PG8_STAGE(PG8_SA(1, 0), a3, voffA);
            PG8_WAIT_V(8); PG8_WAIT_L(0); PG8_BAR; PG8_MMA(1, 0, At, B0); PG8_MMA(1, 1, At, B1); PG8_BAR; PG8_SCHED;
            } else {
            PG8_LDB(B0, 0, 0); PG8_SCHED; PG8_LDA(At, 0, 0); PG8_STAGE(PG8_SA(1, 1), a1 + hstepA, voffA);
            PG8_WAIT_L(8); PG8_BAR; PG8_WAIT_L(0); PG8_MMA(0, 0, At, B0); PG8_BAR; PG8_SCHED;
            PG8_LDB(B1, 0, 1); PG8_STAGE(PG8_SB(0, 0), b2, voffB);
            PG8_BAR; PG8_WAIT_L(0); PG8_MMA(0, 1, At, B1); PG8_BAR;
            PG8_LDA(At, 0, 1); PG8_STAGE(PG8_SA(0, 0), a2, voffA);
            PG8_BAR; PG8_WAIT_L(0); PG8_MMA(1, 0, At, B0); PG8_BAR; PG8_SCHED;
            PG8_STAGE(PG8_SB(0, 1), b2 + hstepB, voffB);
            PG8_WAIT_V(6); PG8_BAR; PG8_MMA(1, 1, At, B1); PG8_BAR;
            PG8_LDB(B0, 1, 0); PG8_SCHED; PG8_LDA(At, 1, 0); PG8_STAGE(PG8_SA(0, 1), a2 + hstepA, voffA);
            PG8_WAIT_L(8); PG8_BAR; PG8_WAIT_L(0); PG8_MMA(0, 0, At, B0); PG8_BAR; PG8_SCHED;
            PG8_LDB(B1, 1, 1); PG8_STAGE(PG8_SB(1, 0), b3, voffB);
            PG8_BAR; PG8_WAIT_L(0); PG8_MMA(0, 1, At, B1); PG8_BAR;
            PG8_LDA(At, 1, 1); PG8_STAGE(PG8_SA(1, 0), a3, voffA);
            PG8_BAR; PG8_WAIT_L(0); PG8_MMA(1, 0, At, B0); PG8_BAR; PG8_SCHED;
            PG8_STAGE(PG8_SB(1, 1), b3 + hstepB, voffB);
            PG8_WAIT_V(6); PG8_BAR; PG8_MMA(1, 1, At, B1); PG8_BAR;
            }
        }
        if constexpr (ALIGN_EPI) { if (wr == 0) PG8_BAR; }
        if constexpr (Epi::RS_NS > 0) {
            PG8_LAS_F float* rsl = (PG8_LAS_F float*)(lds + STAGE_BYTES + 1024);
            if (cur.pm != rs_pm) { rs_pm = cur.pm; fill_rstd_panel<Epi::RS_NS>(E.rs_src(), cur.pm, Epi::RS_INVN, rsl, tid); PG8_WAIT_L(0); PG8_BAR; }
            E(acc, cur, wr, wc, fr, fq, rsl); S.done(cur);
        } else
        if constexpr (!Epi::AFTER_DRAIN) { E(acc, cur, wr, wc, fr, fq); S.done(cur); }
        if (!has_next) break;
#pragma unroll
        for (int a = 0; a < 2; ++a)
#pragma unroll
            for (int b = 0; b < 2; ++b)
#pragma unroll
                for (int m = 0; m < 4; ++m)
#pragma unroll
                    for (int n = 0; n < 2; ++n) acc[a][b][m][n] = (f32x4){0.f, 0.f, 0.f, 0.f};
        cur = nxt; cA = nA; cB = nB; ++ui;
        if constexpr (ALIGN_EPI) { if (wr == 1) PG8_BAR; }
    }
    PG8_WAIT_V(0);
    if constexpr (!ALIGN_EPI) { if (wr == 0) PG8_BAR; }
    PG8_BAR;
    if constexpr (Epi::AFTER_DRAIN) { E.fused(acc, cur, wr, wc, fr, fq, lds, wid, lane); S.done(cur); }
#undef PG8_SA
#undef PG8_SB
#undef PG8_STAGE
#undef PG8_LDA
#undef PG8_LDB
#undef PG8_MMA
#undef PG8_WAIT_V
#undef PG8_WAIT_L
#undef PG8_BAR
#undef PG8_SCHED
}
}


namespace mix {
#define MLAS __attribute__((address_space(3)))
typedef short bf16x8 __attribute__((ext_vector_type(8)));
typedef short s16x4 __attribute__((ext_vector_type(4)));
typedef float f32x16 __attribute__((ext_vector_type(16)));
typedef float f32x4 __attribute__((ext_vector_type(4)));
typedef float f32x2_t __attribute__((ext_vector_type(2))); typedef __bf16 bf16x2_t __attribute__((ext_vector_type(2)));
typedef unsigned u32x4 __attribute__((ext_vector_type(4)));
typedef unsigned u32x2 __attribute__((ext_vector_type(2)));
typedef short v4i16_t __attribute__((ext_vector_type(4)));
#define MFMA32(a, b, c) __builtin_amdgcn_mfma_f32_32x32x16_bf16((a), (b), (c), 0, 0, 0)
__device__ __forceinline__ unsigned cvtpk(float lo, float hi) { f32x2_t v = {lo, hi}; bf16x2_t b = __builtin_convertvector(v, bf16x2_t); return __builtin_bit_cast(unsigned, b); }
__device__ __forceinline__ s16x4 tr_read(const MLAS char* p) { return __builtin_bit_cast(s16x4, __builtin_amdgcn_ds_read_tr16_b64_v4i16((MLAS v4i16_t*)p)); }
__device__ __forceinline__ bf16x8 cat8(s16x4 lo, s16x4 hi) { return __builtin_shufflevector(lo, hi, 0, 1, 2, 3, 4, 5, 6, 7); }
__device__ __forceinline__ int crow(int r, int hi) { return (r & 3) + 8 * (r >> 2) + 4 * hi; }
__device__ __forceinline__ bf16x8 pack_step(const f32x16& x, int s) { u32x4 p; p.x = cvtpk(x[8 * s], x[8 * s + 1]); p.y = cvtpk(x[8 * s + 2], x[8 * s + 3]); p.z = cvtpk(x[8 * s + 4], x[8 * s + 5]); p.w = cvtpk(x[8 * s + 6], x[8 * s + 7]); return __builtin_bit_cast(bf16x8, p); }

constexpr int ATT_KP = 400, ATT_VP = 288, ATT_VOFF = 64 * ATT_KP, ATT_LDS = ATT_VOFF + 64 * ATT_VP;
__device__ __forceinline__ void attn_unit(MLAS char* L, const unsigned char* ws, int b, int h, int qb, int w) {
    const int lane = fresh_lane(), tid = w * 64 + lane, r = lane & 31, hh = lane >> 5;
    const bf16* Q = (const bf16*)(ws + WS_Q); const bf16* KN = (const bf16*)(ws + WS_KN); const bf16* KR = (const bf16*)(ws + WS_KR); const bf16* VV = (const bf16*)(ws + WS_VV); bf16* AR = (bf16*)(ws + WS_AR);
    const int row = b * SEQ + qb * 256 + w * 32 + r;
    bf16x8 qf[12];
#pragma unroll
    for (int s = 0; s < 12; ++s) qf[s] = *(const bf16x8*)(Q + (size_t)row * 1536 + h * 192 + 16 * s + 8 * hh);
    const int my_last = 4 * qb + (w >> 1), ntiles = 4 * qb + 4;
    const char* knb = (const char*)(KN + (size_t)b * SEQ * 1024 + h * 128); const char* krb = (const char*)(KR + (size_t)b * SEQ * 64); const char* vvb = (const char*)(VV + (size_t)b * SEQ * 1024 + h * 128);
    const unsigned noff = ((tid >> 4) * 1024 + (tid & 15) * 8) * 2, roff = tid * 16;
    const int ndst = (tid >> 4) * ATT_KP + (tid & 15) * 16, rdst = (tid >> 3) * ATT_KP + 256 + (tid & 7) * 16, vdst0 = ATT_VOFF + (tid >> 4) * ATT_VP + (tid & 15) * 16;
    u32x4 kreg[3], vreg[2];
    kreg[0] = *(const u32x4*)(knb + noff); kreg[1] = *(const u32x4*)(knb + 65536 + noff); kreg[2] = *(const u32x4*)(krb + roff);
    vreg[0] = *(const u32x4*)(vvb + noff); vreg[1] = *(const u32x4*)(vvb + 65536 + noff);
    f32x16 O[4];
#pragma unroll
    for (int c = 0; c < 4; ++c)
#pragma unroll
        for (int i = 0; i < 16; ++i) O[c][i] = 0.f;
    float m = -1e30f, l = 0.f;
    const int i16 = lane & 15, tr_off = (4 * hh + (i16 >> 2)) * ATT_VP + 32 * ((lane >> 4) & 1) + 8 * (i16 & 3);
#define ATT_STAGE(LB) { *(MLAS u32x4*)((LB) + ndst) = kreg[0]; *(MLAS u32x4*)((LB) + ndst + 32 * ATT_KP) = kreg[1]; *(MLAS u32x4*)((LB) + rdst) = kreg[2]; *(MLAS u32x4*)((LB) + vdst0) = vreg[0]; *(MLAS u32x4*)((LB) + vdst0 + 32 * ATT_VP) = vreg[1]; }
#define ATT_FETCH() { knb += 64 * 1024 * 2; krb += 64 * 64 * 2; vvb += 64 * 1024 * 2; \
        kreg[0] = *(const u32x4*)(knb + noff); kreg[1] = *(const u32x4*)(knb + 65536 + noff); kreg[2] = *(const u32x4*)(krb + roff); vreg[0] = *(const u32x4*)(vvb + noff); vreg[1] = *(const u32x4*)(vvb + 65536 + noff); }
    MLAS char* const L0 = L;
    __syncthreads();
    ATT_STAGE(L0)
    if (ntiles > 1) ATT_FETCH()
    __syncthreads();
    for (int kt = 0; kt < ntiles; ++kt) {
        L = L0 + (kt & 1) * ATT_LDS;
        if (kt + 1 < ntiles) { MLAS char* const LN = L0 + ((kt + 1) & 1) * ATT_LDS; ATT_STAGE(LN) if (kt + 2 < ntiles) ATT_FETCH() }
        if (kt <= my_last) {
            f32x16 s0, s1;
#pragma unroll
            for (int i = 0; i < 16; ++i) { s0[i] = 0.f; s1[i] = 0.f; }
            const MLAS char* kp0 = L + r * ATT_KP + 16 * hh; const MLAS char* kp1 = kp0 + 32 * ATT_KP;
            bf16x8 ka[4], kb[4];
#define ATT_SB __builtin_amdgcn_sched_barrier(0);
#define ATT_KLOAD(buf, s2) _Pragma("unroll") for (int j = 0; j < 2; ++j) { buf[2 * j] = *(const MLAS bf16x8*)(kp0 + 32 * ((s2) + j)); buf[2 * j + 1] = *(const MLAS bf16x8*)(kp1 + 32 * ((s2) + j)); } ATT_SB
#define ATT_KMMA(buf, s2) _Pragma("unroll") for (int j = 0; j < 2; ++j) { s0 = MFMA32(buf[2 * j], qf[(s2) + j], s0); s1 = MFMA32(buf[2 * j + 1], qf[(s2) + j], s1); } ATT_SB
            const MLAS char* vp = L + ATT_VOFF + tr_off;
            s16x4 va[8], vb[8];
#define ATT_VLOAD(buf, ks) _Pragma("unroll") for (int c = 0; c < 4; ++c) { buf[2 * c] = tr_read(vp + (16 * (ks)) * ATT_VP + 64 * c); buf[2 * c + 1] = tr_read(vp + (16 * (ks) + 8) * ATT_VP + 64 * c); } ATT_SB
#define ATT_VMMA(buf, ks) _Pragma("unroll") for (int c = 0; c < 4; ++c) O[c] = MFMA32(cat8(buf[2 * c], buf[2 * c + 1]), pf[ks], O[c]); ATT_SB
            ATT_KLOAD(ka, 0) ATT_KLOAD(kb, 2) ATT_KMMA(ka, 0) ATT_KLOAD(ka, 4) ATT_KMMA(kb, 2) ATT_KLOAD(kb, 6) ATT_KMMA(ka, 4) ATT_KLOAD(ka, 8) ATT_KMMA(kb, 6) ATT_KLOAD(kb, 10) ATT_KMMA(ka, 8) ATT_VLOAD(va, 0) ATT_KMMA(kb, 10)
            float mx = s0[0];
#pragma unroll
            for (int i = 1; i < 16; ++i) mx = fmaxf(mx, s0[i]);
#pragma unroll
            for (int i = 0; i < 16; ++i) mx = fmaxf(mx, s1[i]);
            mx = fmaxf(mx, __shfl_xor(mx, 32));
            if (__any(mx > m + 8.f)) { const float mn = fmaxf(m, mx), alpha = __builtin_amdgcn_exp2f(m - mn); m = mn; l *= alpha;
#pragma unroll
                for (int c = 0; c < 4; ++c)
#pragma unroll
                    for (int i = 0; i < 16; ++i) O[c][i] *= alpha; }
            float ps = 0.f;
#pragma unroll
            for (int i = 0; i < 16; ++i) { s0[i] = __builtin_amdgcn_exp2f(s0[i] - m); s1[i] = __builtin_amdgcn_exp2f(s1[i] - m); ps += s0[i] + s1[i]; }
            ps += __shfl_xor(ps, 32);
            l += ps;
            bf16x8 pf[4]; pf[0] = pack_step(s0, 0); pf[1] = pack_step(s0, 1); pf[2] = pack_step(s1, 0); pf[3] = pack_step(s1, 1);
            ATT_SB
            ATT_VLOAD(vb, 1) ATT_VMMA(va, 0) ATT_VLOAD(va, 2) ATT_VMMA(vb, 1) ATT_VLOAD(vb, 3) ATT_VMMA(va, 2) ATT_VMMA(vb, 3)
        }
        __syncthreads();
    }
    const float inv = __builtin_amdgcn_rcpf(l);
    const int lane2 = fresh_lane();
    bf16* orow = (bf16*)(ws + WS_AR) + (size_t)(b * SEQ + qb * 256 + w * 32 + (lane2 & 31)) * 3072 + h * 128 + 4 * (lane2 >> 5);
#pragma unroll
    for (int c = 0; c < 4; ++c)
#pragma unroll
        for (int g = 0; g < 4; ++g) { u32x2 o; o.x = cvtpk(O[c][4 * g] * inv, O[c][4 * g + 1] * inv); o.y = cvtpk(O[c][4 * g + 2] * inv, O[c][4 * g + 3] * inv); *(u32x2*)(orow + 32 * c + 8 * g) = o; }
}
constexpr int RT_QP = 288, RT_QQ = 296  , RT_VP = 544, RT_AP = 144, RT_Q = 0, RT_K = 64 * RT_QQ, RT_V = RT_K + 64 * RT_QP, RT_A = RT_V + 64 * RT_VP, RT_ST = RT_A + 64 * RT_AP, RT_LDS = RT_ST + 8 * 64 * 8;
__device__ __forceinline__ bf16x8 scale8(u32x4 v, float f) {
    u32x4 o; o.x = cvtpk(__uint_as_float(v.x << 16) * f, __uint_as_float(v.x & 0xffff0000u) * f); o.y = cvtpk(__uint_as_float(v.y << 16) * f, __uint_as_float(v.y & 0xffff0000u) * f);
    o.z = cvtpk(__uint_as_float(v.z << 16) * f, __uint_as_float(v.z & 0xffff0000u) * f); o.w = cvtpk(__uint_as_float(v.w << 16) * f, __uint_as_float(v.w & 0xffff0000u) * f); return __builtin_bit_cast(bf16x8, o); }
constexpr int RT_NSEG = 8, RT_NCH = (SEQ / 64) / RT_NSEG;
template <int MODE> __device__ __forceinline__ void ret_unit(MLAS char* L, unsigned char* ws, float* rl, float* sout, int b, int h, int seg, int w) {
    const int lane = fresh_lane(), tid = w * 64 + lane, r = lane & 31, hh = lane >> 5;
    const bf16* RQ = (const bf16*)(ws + WS_RQ); const bf16* RK = (const bf16*)(ws + WS_RK); const bf16* RV = (const bf16*)(ws + WS_RV); const bf16* RG = (const bf16*)(ws + WS_RG); bf16* AR = (bf16*)(ws + WS_AR);
    const float lg = log2f(1.f - exp2f(-5.f - (float)h));
    const float cdec = exp2f(64.f * lg);
    const char* qbase = (const char*)(RQ + ((size_t)b * SEQ + seg * RT_NCH * 64) * 1024 + h * 128); const char* kbase = (const char*)(RK + ((size_t)b * SEQ + seg * RT_NCH * 64) * 1024 + h * 128);
    const char* vbase = (const char*)(RV + ((size_t)b * SEQ + seg * RT_NCH * 64) * 2048 + h * 256);
    const unsigned qoff = ((tid >> 4) * 1024 + (tid & 15) * 8) * 2, voff = ((tid >> 5) * 2048 + (tid & 31) * 8) * 2;
    const int qdst0 = (tid >> 4) * RT_QP + (tid & 15) * 16, qdstq = (tid >> 4) * RT_QQ + (tid & 15) * 16, vdst0 = RT_V + (tid >> 5) * RT_VP + (tid & 31) * 16;
    float kf[2], qs[2];
#pragma unroll
    for (int i = 0; i < 2; ++i) { const int row = (tid >> 4) + 32 * i; kf[i] = exp2f(lg * (float)(63 - row)); qs[i] = exp2f(lg * (float)(row + 1)); }
    u32x4 qreg[2], kreg[2], vreg[4];
#pragma unroll
    for (int i = 0; i < 2; ++i) { if (MODE == 1) qreg[i] = *(const u32x4*)(qbase + 65536 * i + qoff); kreg[i] = *(const u32x4*)(kbase + 65536 * i + qoff); }
#pragma unroll
    for (int i = 0; i < 4; ++i) vreg[i] = *(const u32x4*)(vbase + 65536 * i + voff);
    f32x16 S[4];
#pragma unroll
    for (int kt = 0; kt < 4; ++kt)
#pragma unroll
        for (int i = 0; i < 16; ++i) S[kt][i] = 0.f;
    float* rlu = rl + ((size_t)(b * 8 + h) * RT_NSEG) * 32768 + 32 * w + r;
    if (MODE == 1) { const float cseg = exp2f((float)(RT_NCH * 64) * lg);
        for (int g = 0; g < seg; ++g) { const float* lp = rlu + (size_t)g * 32768;
#pragma unroll
            for (int kt = 0; kt < 4; ++kt)
#pragma unroll
                for (int i = 0; i < 16; ++i) S[kt][i] = S[kt][i] * cseg + lp[(32 * kt + crow(i, hh)) * 256]; } }
    const int i16 = lane & 15, q4 = i16 >> 2, blk = (lane >> 4) & 1, p4 = i16 & 3;
    const MLAS char* trv = L + RT_V + (8 * hh + q4) * RT_VP + 64 * w + 32 * blk + 8 * p4;
    const MLAS char* trk = L + RT_K + (8 * hh + q4) * RT_QP + 32 * blk + 8 * p4;
    const float icdec = exp2f(-64.f * lg);
#define RT_SB __builtin_amdgcn_sched_barrier(0);
    for (int n = 0; n < RT_NCH; ++n) {
        __syncthreads();
#pragma unroll
        for (int i = 0; i < 2; ++i) { if (MODE == 1) { const bf16x8 qv = scale8(qreg[i], qs[i]); MLAS char* qd = L + RT_Q + qdstq + 32 * RT_QQ * i; *(MLAS s16x4*)qd = __builtin_shufflevector(qv, qv, 0, 1, 2, 3); *(MLAS s16x4*)(qd + 8) = __builtin_shufflevector(qv, qv, 4, 5, 6, 7); } *(MLAS bf16x8*)(L + RT_K + qdst0 + 32 * RT_QP * i) = scale8(kreg[i], kf[i]); }
#pragma unroll
        for (int i = 0; i < 4; ++i) *(MLAS u32x4*)(L + vdst0 + 16 * RT_VP * i) = vreg[i];
        __syncthreads();
        if (n + 1 < RT_NCH) {
            qbase += 64 * 1024 * 2; kbase += 64 * 1024 * 2; vbase += 64 * 2048 * 2;
#pragma unroll
            for (int i = 0; i < 2; ++i) { if (MODE == 1) qreg[i] = *(const u32x4*)(qbase + 65536 * i + qoff); kreg[i] = *(const u32x4*)(kbase + 65536 * i + qoff); }
#pragma unroll
            for (int i = 0; i < 4; ++i) vreg[i] = *(const u32x4*)(vbase + 65536 * i + voff);
        }
        u32x2 gv[2][4];
        const size_t rowu = (size_t)b * SEQ + (seg * RT_NCH + n) * 64;
        if (MODE == 1) { const char* gb = (const char*)(RG + rowu * 2048 + h * 256 + 32 * w); const unsigned go = (r * 2048 + 4 * hh) * 2;
#pragma unroll
            for (int qi = 0; qi < 2; ++qi)
#pragma unroll
                for (int g = 0; g < 4; ++g) gv[qi][g] = *(const u32x2*)(gb + (32 * qi * 2048 + 8 * g) * 2 + go);
        }
        if (MODE == 1 && w < 3) {
            const int kj = w >> 1, qi = (w + 1) >> 1;
            const MLAS char* kp = L + RT_K + (32 * kj + r) * RT_QP + 16 * hh; const MLAS char* qp = L + RT_Q + (32 * qi + r) * RT_QQ + 16 * hh;
            bf16x8 fk[8], fq[8];
#pragma unroll
            for (int s = 0; s < 8; ++s) { fk[s] = *(const MLAS bf16x8*)(kp + 32 * s); fq[s] = cat8(*(const MLAS s16x4*)(qp + 32 * s), *(const MLAS s16x4*)(qp + 32 * s + 8)); }
            RT_SB
            f32x16 a;
#pragma unroll
            for (int i = 0; i < 16; ++i) a[i] = 0.f;
#pragma unroll
            for (int s = 0; s < 8; ++s) a = MFMA32(fk[s], fq[s], a);
            RT_SB
            const int q = 32 * qi + r;
#pragma unroll
            for (int g = 0; g < 4; ++g) { float v[4];
#pragma unroll
                for (int e = 0; e < 4; ++e) { const int key = 32 * kj + 8 * g + 4 * hh + e; v[e] = key <= q ? a[4 * g + e] * icdec : 0.f; }
                u32x2 o; o.x = cvtpk(v[0], v[1]); o.y = cvtpk(v[2], v[3]); *(MLAS u32x2*)(L + RT_A + q * RT_AP + (32 * kj + 8 * g + 4 * hh) * 2) = o; }
        }
        if (MODE == 1) __syncthreads();
        s16x4 vt[8];
#pragma unroll
        for (int ks = 0; ks < 4; ++ks) { vt[2 * ks] = tr_read(trv + 16 * ks * RT_VP); vt[2 * ks + 1] = tr_read(trv + (16 * ks + 4) * RT_VP); }
        f32x16 o[2];
        s16x4 ka[8], kb[8];
#define RT_KLOAD(buf, kt) _Pragma("unroll") for (int ks = 0; ks < 4; ++ks) { buf[2 * ks] = tr_read(trk + 64 * (kt) + 16 * ks * RT_QP); buf[2 * ks + 1] = tr_read(trk + 64 * (kt) + (16 * ks + 4) * RT_QP); } RT_SB
#define RT_KMMA(buf, kt) _Pragma("unroll") for (int ks = 0; ks < 4; ++ks) S[kt] = MFMA32(cat8(buf[2 * ks], buf[2 * ks + 1]), cat8(vt[2 * ks], vt[2 * ks + 1]), S[kt]); RT_SB
        if (MODE == 1) {
            const MLAS char* ap = L + RT_A + r * RT_AP + 16 * hh;
            bf16x8 af[6];
#pragma unroll
            for (int ks = 0; ks < 4; ++ks) { if (ks < 2) af[ks] = *(const MLAS bf16x8*)(ap + 32 * ks); af[2 + ks] = *(const MLAS bf16x8*)(ap + 32 * RT_AP + 32 * ks); }
            const MLAS char* qp = L + RT_Q + r * RT_QQ + 8 * hh;
            s16x4 qa[8], qb[8];
#define RT_QLOAD(buf, kt) _Pragma("unroll") for (int s = 0; s < 2; ++s) _Pragma("unroll") for (int qi = 0; qi < 2; ++qi) { const MLAS char* pp = qp + 32 * qi * RT_QQ + (32 * (kt) + 16 * s) * 2; buf[4 * s + 2 * qi] = *(const MLAS s16x4*)pp; buf[4 * s + 2 * qi + 1] = *(const MLAS s16x4*)(pp + 16); } RT_SB
#define RT_QMMA(buf, kt) _Pragma("unroll") for (int s = 0; s < 2; ++s) { const bf16x8 sf = pack_step(S[kt], s); _Pragma("unroll") for (int qi = 0; qi < 2; ++qi) o[qi] = MFMA32(sf, cat8(buf[4 * s + 2 * qi], buf[4 * s + 2 * qi + 1]), o[qi]); } RT_SB
            RT_QLOAD(qa, 0)
#pragma unroll
            for (int qi = 0; qi < 2; ++qi)
#pragma unroll
                for (int i = 0; i < 16; ++i) o[qi][i] = 0.f;
#pragma unroll
            for (int ks = 0; ks < 4; ++ks) { if (ks < 2) o[0] = MFMA32(cat8(vt[2 * ks], vt[2 * ks + 1]), af[ks], o[0]); o[1] = MFMA32(cat8(vt[2 * ks], vt[2 * ks + 1]), af[2 + ks], o[1]); }
            RT_SB
            RT_QLOAD(qb, 1) RT_QMMA(qa, 0) RT_QLOAD(qa, 2) RT_QMMA(qb, 1) RT_QLOAD(qb, 3) RT_QMMA(qa, 2) RT_KLOAD(ka, 0) RT_QMMA(qb, 3)
        } else { RT_KLOAD(ka, 0) }
#pragma unroll
        for (int kt = 0; kt < 4; ++kt)
#pragma unroll
            for (int i = 0; i < 16; ++i) S[kt][i] *= cdec;
        RT_SB
        RT_KLOAD(kb, 1) RT_KMMA(ka, 0) RT_KLOAD(ka, 2) RT_KMMA(kb, 1) RT_KLOAD(kb, 3) RT_KMMA(ka, 2) RT_KMMA(kb, 3)
        if (MODE == 1) {
#pragma unroll
        for (int qi = 0; qi < 2; ++qi) { float a1 = 0.f, a2 = 0.f;
#pragma unroll
            for (int i = 0; i < 16; ++i) { const float ov = o[qi][i]; a1 += ov; a2 += ov * ov; }
            a1 += __shfl_xor(a1, 32); a2 += __shfl_xor(a2, 32);
            if (hh == 0) *(MLAS f32x2_t*)(L + RT_ST + (w * 64 + 32 * qi + r) * 8) = (f32x2_t){a1, a2}; }
        __syncthreads();
#pragma unroll
        for (int qi = 0; qi < 2; ++qi) { float t1 = 0.f, t2 = 0.f;
#pragma unroll
            for (int ww = 0; ww < 8; ++ww) { const f32x2_t t = *(const MLAS f32x2_t*)(L + RT_ST + (ww * 64 + 32 * qi + r) * 8); t1 += t[0]; t2 += t[1]; }
            const float mu = t1 * (1.f / 256.f), var = t2 * (1.f / 256.f) - mu * mu, rstd = rsqrtf(var + GN_EPS);
            bf16* op = (bf16*)((char*)(AR + (rowu + 32 * qi) * 3072 + 1024 + h * 256 + 32 * w) + (unsigned)((r * 3072 + 4 * hh) * 2));
#pragma unroll
            for (int g = 0; g < 4; ++g) { const u32x2 gvv = gv[qi][g];
                u32x2 ov; ov.x = cvtpk((o[qi][4 * g] - mu) * rstd * __uint_as_float(gvv.x << 16), (o[qi][4 * g + 1] - mu) * rstd * __uint_as_float(gvv.x & 0xffff0000u));
                ov.y = cvtpk((o[qi][4 * g + 2] - mu) * rstd * __uint_as_float(gvv.y << 16), (o[qi][4 * g + 3] - mu) * rstd * __uint_as_float(gvv.y & 0xffff0000u));
                *(u32x2*)(op + 8 * g) = ov; } }
        }
    }
    if (MODE == 0 || seg == RT_NSEG - 1) { float* dst = MODE == 0 ? rlu + (size_t)seg * 32768 : sout + 32 * w + r;
#pragma unroll
        for (int kt = 0; kt < 4; ++kt)
#pragma unroll
            for (int i = 0; i < 16; ++i) dst[(size_t)(32 * kt + crow(i, hh)) * 256] = S[kt][i]; }
}
constexpr int SA_FLOATS = 128 + 64 + 512 + (PAST_LEN + DEC_SEQ) + 512 + 8;
__device__ __forceinline__ float half_sum(float v, MLAS float* red, int t) {
    for (int o = 32; o >= 1; o >>= 1) v += __shfl_xor(v, o);
    __syncthreads(); if ((t & 63) == 0) red[t >> 6] = v; __syncthreads();
    return (red[0] + red[1]) + (red[2] + red[3]);
}
__device__ __forceinline__ void sample_attn_item(MLAS float* Lh, const unsigned char* ws, const float* cache_c, const float* cache_kr, const float* newc, const float* newkr, const float* wuk, const float* wuv,
                                                 int b, int tok, int h, int t) {
    MLAS float *qn = Lh, *qr = Lh + 128, *ql = Lh + 192, *sc = Lh + 704, *ol = Lh + 704 + PAST_LEN + DEC_SEQ, *red = ol + 512;
    const bf16* Q = (const bf16*)(ws + WS_Q); bf16* AR = (bf16*)(ws + WS_AR);
    const int row = MP + b * DEC_SEQ + tok, NK = PAST_LEN + DEC_SEQ;
    __syncthreads();
    if (t < 192) Lh[t] = bf2f(Q[(size_t)row * 1536 + h * 192 + t]);
    __syncthreads();
    for (int r = t; r < 512; r += 256) { float s = 0.f; const float* wp = wuk + (size_t)r * 1024 + h * 128; for (int d = 0; d < 128; ++d) s += qn[d] * wp[d]; ql[r] = s; }
    __syncthreads();
    float mx = -1e30f;
    for (int k = t; k < NK; k += 256) {
        const float* c = k < PAST_LEN ? cache_c + ((size_t)b * PAST_LEN + k) * 512 : newc + ((size_t)b * DEC_SEQ + (k - PAST_LEN)) * 512;
        const float* kr = k < PAST_LEN ? cache_kr + ((size_t)b * PAST_LEN + k) * 64 : newkr + ((size_t)b * DEC_SEQ + (k - PAST_LEN)) * 64;
        float s = 0.f; for (int r = 0; r < 512; ++r) s += ql[r] * c[r]; for (int e = 0; e < 64; ++e) s += qr[e] * kr[e];
        sc[k] = s; mx = fmaxf(mx, s); }
    for (int o = 32; o >= 1; o >>= 1) mx = fmaxf(mx, __shfl_xor(mx, o));
    __syncthreads(); if ((t & 63) == 0) red[t >> 6] = mx; __syncthreads();
    mx = fmaxf(fmaxf(red[0], red[1]), fmaxf(red[2], red[3]));
    float ls = 0.f;
    for (int k = t; k < NK; k += 256) { const float p = exp2f(sc[k] - mx); sc[k] = p; ls += p; }
    ls = half_sum(ls, red, t);
    const float inv = 1.f / ls;
    for (int r = t; r < 512; r += 256) { float s = 0.f;
        for (int k = 0; k < NK; ++k) { const float* c = k < PAST_LEN ? cache_c + ((size_t)b * PAST_LEN + k) * 512 : newc + ((size_t)b * DEC_SEQ + (k - PAST_LEN)) * 512; s += sc[k] * c[r]; }
        ol[r] = s * inv; }
    __syncthreads();
    if (t < 128) { float s = 0.f; for (int r = 0; r < 512; ++r) s += ol[r] * wuv[(size_t)r * 1024 + h * 128 + t]; AR[(size_t)row * 3072 + h * 128 + t] = f2bf(s); }
}
__device__ __forceinline__ void sample_ret_item(MLAS float* Lh, const unsigned char* ws, const float* S0, float* Sout, int bh, int t) {
    const bf16* RQ = (const bf16*)(ws + WS_RQ); const bf16* RK = (const bf16*)(ws + WS_RK); const bf16* RV = (const bf16*)(ws + WS_RV); const bf16* RG = (const bf16*)(ws + WS_RG); bf16* AR = (bf16*)(ws + WS_AR);
    const int b = bh >> 3, h = bh & 7, wv = t >> 6;
    const float g = 1.f - exp2f(-5.f - (float)h);
    MLAS float* osh = Lh + 128;
    MLAS unsigned* qk = (MLAS unsigned*)((MLAS char*)Lh + 40960);
#pragma unroll
    for (int i = 0; i < 2; ++i) { const int c = t + 256 * i, tok = c >> 5, part = c & 31; const size_t row = (size_t)(MP + b * DEC_SEQ + tok) * 1024 + h * 128;
        *(MLAS u32x4*)(qk + tok * 128 + part * 4) = part < 16 ? *(const u32x4*)(RQ + row + part * 8) : *(const u32x4*)(RK + row + (part - 16) * 8); }
    float S[128];
#pragma unroll
    for (int d = 0; d < 128; ++d) S[d] = S0[((size_t)bh * 128 + d) * 256 + t];
    __syncthreads();
    const bf16* rvp = RV + (size_t)(MP + b * DEC_SEQ) * 2048 + h * 256 + t; float vnext = bf2f(rvp[0]);
#pragma unroll 1
    for (int tk = 0; tk < DEC_SEQ; ++tk) {
        const float v = vnext; vnext = bf2f(rvp[(size_t)(tk + 1 < DEC_SEQ ? tk + 1 : tk) * 2048]);
        const MLAS unsigned* q = qk + tk * 128; const MLAS unsigned* k = q + 64; float acc = 0.f;
#pragma unroll
        for (int d2 = 0; d2 < 64; ++d2) { const unsigned kk = k[d2], qq = q[d2];
            S[2 * d2] = g * S[2 * d2] + __uint_as_float(kk << 16) * v; acc += __uint_as_float(qq << 16) * S[2 * d2];
            S[2 * d2 + 1] = g * S[2 * d2 + 1] + __uint_as_float(kk & 0xffff0000u) * v; acc += __uint_as_float(qq & 0xffff0000u) * S[2 * d2 + 1]; }
        osh[tk * 256 + t] = acc;
        float s1 = acc, s2 = acc * acc;
#pragma unroll
        for (int x = 32; x >= 1; x >>= 1) { s1 += __shfl_xor(s1, x); s2 += __shfl_xor(s2, x); }
        if ((t & 63) == 0) { Lh[(wv * DEC_SEQ + tk) * 2] = s1; Lh[(wv * DEC_SEQ + tk) * 2 + 1] = s2; }
    }
#pragma unroll
    for (int d = 0; d < 128; ++d) Sout[((size_t)bh * 128 + d) * 256 + t] = S[d];
    __syncthreads();
#pragma unroll 1
    for (int tk = 0; tk < DEC_SEQ; ++tk) { float s1 = 0.f, s2 = 0.f;
#pragma unroll
        for (int ww = 0; ww < 4; ++ww) { s1 += Lh[(ww * DEC_SEQ + tk) * 2]; s2 += Lh[(ww * DEC_SEQ + tk) * 2 + 1]; }
        const float mu = s1 * (1.f / 256.f), var = s2 * (1.f / 256.f) - mu * mu, rstd = rsqrtf(var + GN_EPS); const int row = MP + b * DEC_SEQ + tk;
        AR[(size_t)row * 3072 + 1024 + h * 256 + t] = f2bf(bf2f(RG[(size_t)row * 2048 + h * 256 + t]) * (osh[tk * 256 + t] - mu) * rstd); }
}
constexpr int SM_CP = 1168, SM_NT = 33, SM_ROWS = 64 * SM_NT;
typedef float f32x4m __attribute__((ext_vector_type(4)));
#define MFMA16(a, b, c) __builtin_amdgcn_mfma_f32_16x16x32_bf16((a), (b), (c), 0, 0, 0)
__device__ __forceinline__ bf16x8 pack44(const f32x4m& a, const f32x4m& b) { u32x4 p; p.x = cvtpk(a[0], a[1]); p.y = cvtpk(a[2], a[3]); p.z = cvtpk(b[0], b[1]); p.w = cvtpk(b[2], b[3]); return __builtin_bit_cast(bf16x8, p); }
__device__ __forceinline__ void sample_attn_unit(MLAS char* L, unsigned char* ws, const float* wuk, const float* wuv, int b, int hg, int w) {
    const int lane = fresh_lane(), tid = w * 64 + lane, c16 = lane & 15, kg = lane >> 4;
    const int head = 4 * hg + (w & 3), rh = w >> 2, rbase = 256 * rh;
    const bf16* Q = (const bf16*)(ws + WS_Q); const bf16* CALL = (const bf16*)(ws + WS_CALL) + (size_t)b * SM_ROWS * 576; bf16* AR = (bf16*)(ws + WS_AR);
    const size_t qrow = (size_t)(MP + b * DEC_SEQ + c16) * 1536 + head * 192;
    bf16x8 qlf[16];
    {
        bf16x8 qnf[4];
#pragma unroll
        for (int s = 0; s < 4; ++s) qnf[s] = *(const bf16x8*)(Q + qrow + 32 * s + 8 * kg);
#pragma unroll
        for (int s2 = 0; s2 < 16; ++s2) { f32x4m a0 = {0.f, 0.f, 0.f, 0.f}, a1 = {0.f, 0.f, 0.f, 0.f};
            f32x4m wl[4][4];
#pragma unroll
            for (int s = 0; s < 4; ++s) { const float* p0 = wuk + (size_t)(32 * s2 + c16) * 1024 + head * 128 + 32 * s + 8 * kg; const float* p1 = p0 + 16 * 1024;
                wl[s][0] = *(const f32x4m*)p0; wl[s][1] = *(const f32x4m*)(p0 + 4); wl[s][2] = *(const f32x4m*)p1; wl[s][3] = *(const f32x4m*)(p1 + 4); }
            __builtin_amdgcn_sched_barrier(0);
#pragma unroll
            for (int s = 0; s < 4; ++s) { a0 = MFMA16(pack44(wl[s][0], wl[s][1]), qnf[s], a0); a1 = MFMA16(pack44(wl[s][2], wl[s][3]), qnf[s], a1); }
            __builtin_amdgcn_sched_barrier(0);
            qlf[s2] = pack44(a0, a1); }
    }
    MLAS char* const qrl = L + 76800 + w * 2048 + lane * 16;
    __syncthreads();
#pragma unroll
    for (int s = 0; s < 2; ++s) *(MLAS bf16x8*)(qrl + 1024 * s) = *(const bf16x8*)(Q + qrow + 128 + 32 * s + 8 * kg);
    const char* cbase = (const char*)CALL; const unsigned coff = tid * 16;
    u32x4 sreg[9];
#pragma unroll
    for (int i = 0; i < 9; ++i) sreg[i] = *(const u32x4*)(cbase + 8192 * i + coff);
    f32x4m O[16];
#pragma unroll
    for (int rt = 0; rt < 16; ++rt) O[rt] = (f32x4m){0.f, 0.f, 0.f, 0.f};
    float m = -1e30f, l = 0.f;
    const int i16 = lane & 15;
    const MLAS char* kp0 = L + c16 * SM_CP + 8 * kg;
    const MLAS char* vp0 = L + (4 * kg + (i16 >> 2)) * SM_CP + rbase * 2 + 8 * (i16 & 3);
#define SM_SB __builtin_amdgcn_sched_barrier(0);
    for (int kt = 0; kt < SM_NT; ++kt) {
        __syncthreads();
        { const int tid2 = w * 64 + fresh_lane();
#pragma unroll
          for (int i = 0; i < 9; ++i) { const int c = tid2 + 512 * i, key = c / 72; *(MLAS u32x4*)(L + c * 16 + key * (SM_CP - 1152)) = sreg[i]; } }
        __syncthreads();
        if (kt + 1 < SM_NT) { cbase += 64 * 576 * 2;
#pragma unroll
            for (int i = 0; i < 4; ++i) sreg[i] = *(const u32x4*)(cbase + 8192 * i + coff); }
        f32x4m s[4]; s16x4 kbuf[2][8], vbuf[3][4]; bf16x8 rf[2], qr[2];
#define SM_KLOAD(buf, f) _Pragma("unroll") for (int j = 0; j < 4; ++j) { const MLAS char* pp = kp0 + 16 * ((f) >> 2) * SM_CP + 64 * (4 * ((f) & 3) + j); buf[2 * j] = *(const MLAS s16x4*)pp; buf[2 * j + 1] = *(const MLAS s16x4*)(pp + 32); }
#define SM_VLOAD(buf, rt) { const MLAS char* pp = vp0 + 32 * (rt); buf[0] = tr_read(pp); buf[1] = tr_read(pp + 16 * SM_CP); buf[2] = tr_read(pp + 32 * SM_CP); buf[3] = tr_read(pp + 48 * SM_CP); }
        SM_KLOAD(kbuf[0], 0) SM_SB
#pragma unroll
        for (int f = 0; f < 16; ++f) { const int mt = f >> 2, q = f & 3;
            if (f < 15) { SM_KLOAD(kbuf[(f + 1) & 1], f + 1) } else { SM_VLOAD(vbuf[0], 0) SM_VLOAD(vbuf[1], 1) }
            if (q == 3) { const MLAS char* rp = L + (16 * mt + c16) * SM_CP + (512 + 8 * kg) * 2; rf[0] = *(const MLAS bf16x8*)rp; rf[1] = *(const MLAS bf16x8*)(rp + 64); qr[0] = *(const MLAS bf16x8*)qrl; qr[1] = *(const MLAS bf16x8*)(qrl + 1024); }
            SM_SB
            if (q == 0) s[mt] = (f32x4m){0.f, 0.f, 0.f, 0.f};
#pragma unroll
            for (int j = 0; j < 4; ++j) s[mt] = MFMA16(cat8(kbuf[f & 1][2 * j], kbuf[f & 1][2 * j + 1]), qlf[4 * q + j], s[mt]);
            if (q == 3) { s[mt] = MFMA16(rf[0], qr[0], s[mt]); s[mt] = MFMA16(rf[1], qr[1], s[mt]); }
            SM_SB
        }
        if (kt == SM_NT - 1) { s[1] = (f32x4m){-1e30f, -1e30f, -1e30f, -1e30f}; s[2] = s[1]; s[3] = s[1]; }
        float mx = -1e30f;
#pragma unroll
        for (int mt = 0; mt < 4; ++mt) mx = fmaxf(mx, fmaxf(fmaxf(s[mt][0], s[mt][1]), fmaxf(s[mt][2], s[mt][3])));
        mx = fmaxf(mx, __shfl_xor(mx, 16)); mx = fmaxf(mx, __shfl_xor(mx, 32));
        if (__any(mx > m)) { const float mn = fmaxf(m, mx), alpha = __builtin_amdgcn_exp2f(m - mn); m = mn; l *= alpha;
#pragma unroll
            for (int rt = 0; rt < 16; ++rt) O[rt] *= alpha; }
        float ps = 0.f;
#pragma unroll
        for (int mt = 0; mt < 4; ++mt)
#pragma unroll
            for (int i = 0; i < 4; ++i) { s[mt][i] = __builtin_amdgcn_exp2f(s[mt][i] - m); ps += s[mt][i]; }
        ps += __shfl_xor(ps, 16); ps += __shfl_xor(ps, 32);
        l += ps;
        const bf16x8 pf0 = pack44(s[0], s[1]), pf1 = pack44(s[2], s[3]);
        SM_SB
        if (kt + 1 < SM_NT) {
#pragma unroll
            for (int i = 4; i < 9; ++i) sreg[i] = *(const u32x4*)(cbase + 8192 * i + coff); }
        SM_SB
#pragma unroll
        for (int rt = 0; rt < 16; ++rt) {
            if (rt < 14) { SM_VLOAD(vbuf[(rt + 2) % 3], rt + 2) }
            SM_SB
            O[rt] = MFMA16(cat8(vbuf[rt % 3][0], vbuf[rt % 3][1]), pf0, O[rt]); O[rt] = MFMA16(cat8(vbuf[rt % 3][2], vbuf[rt % 3][3]), pf1, O[rt]);
            SM_SB
        }
    }
    const float invl = 1.f / l;
    const int lane3 = fresh_lane(), c16b = lane3 & 15, kgb = lane3 >> 4;
    bf16x8 of[8];
#pragma unroll
    for (int s3 = 0; s3 < 8; ++s3) of[s3] = pack44(O[2 * s3] * invl, O[2 * s3 + 1] * invl);
    f32x4m acc[8];
    const char* wvb = (const char*)(wuv + (size_t)rbase * 1024 + head * 128); const unsigned wvo = (4 * kgb * 1024 + c16b) * 4;
#pragma unroll
    for (int dt = 0; dt < 8; ++dt) { acc[dt] = (f32x4m){0.f, 0.f, 0.f, 0.f};
#pragma unroll
        for (int hs = 0; hs < 2; ++hs) {
            f32x4m wlo[4], whi[4];
#pragma unroll
            for (int s4 = 0; s4 < 4; ++s4) { const char* wp = wvb + ((size_t)(32 * (4 * hs + s4)) * 1024 + 16 * dt) * 4;
#define SM_WL(k) (*(const float*)(wp + (size_t)(k) * 4096 + wvo))
                wlo[s4] = (f32x4m){SM_WL(0), SM_WL(1), SM_WL(2), SM_WL(3)}; whi[s4] = (f32x4m){SM_WL(16), SM_WL(17), SM_WL(18), SM_WL(19)}; }
            __builtin_amdgcn_sched_barrier(0);
#pragma unroll
            for (int s4 = 0; s4 < 4; ++s4) acc[dt] = MFMA16(pack44(wlo[s4], whi[s4]), of[4 * hs + s4], acc[dt]);
            __builtin_amdgcn_sched_barrier(0); } }
    const int lane4 = fresh_lane(), c16c = lane4 & 15, kgc = lane4 >> 4;
    __syncthreads();
    MLAS f32x4m* X = (MLAS f32x4m*)L + ((w & 3) * 8) * 64 + lane4;
    if (rh == 1) {
#pragma unroll
        for (int dt = 0; dt < 8; ++dt) X[dt * 64] = acc[dt]; }
    __syncthreads();
    if (rh == 0) { bf16* op = AR + (size_t)(MP + b * DEC_SEQ + c16c) * 3072 + head * 128 + 4 * kgc;
#pragma unroll
        for (int dt = 0; dt < 8; ++dt) { const f32x4m v = acc[dt] + X[dt * 64]; u32x2 o; o.x = cvtpk(v[0], v[1]); o.y = cvtpk(v[2], v[3]); *(u32x2*)(op + 16 * dt) = o; } }
}
}

namespace mk {
#define GAS __attribute__((address_space(1)))
#define LAS __attribute__((address_space(3)))
typedef unsigned v4u __attribute__((ext_vector_type(4)));
typedef float f32x4 __attribute__((ext_vector_type(4)));
typedef GAS unsigned gu32;
#define LDS_WAIT() asm volatile("s_waitcnt lgkmcnt(0)" ::: "memory")
#define VM_WAIT() asm volatile("s_waitcnt vmcnt(0)" ::: "memory")
constexpr int NWAVES = 8;
constexpr int RING_OFF = 0, RING_BYTES = 131072, LDSCTL_OFF = RING_BYTES, MISC_OFF = LDSCTL_OFF + 320, LDS_BYTES = 147456;
constexpr int CW_BAR = 4096;
constexpr int CW_QUEUE = 8192;

#define XB_TMO      128
#define XB_XCNT(j)  (256  + 64 * (j))
#define XB_XSUB(j)  (1280 + 64 * (j))
#define XB_XGEN(j)  (2304 + 64 * (j))
#define XB_TOP      3328
#define XB_TOPGEN   3392
#define XCD_BAR_WORDS 3456
#define XB_SPIN_CAP (1u << 18)

__device__ __forceinline__ unsigned xb_ld(unsigned* p)              { return __hip_atomic_load(p, __ATOMIC_RELAXED, __HIP_MEMORY_SCOPE_AGENT); }
__device__ __forceinline__ unsigned xb_add(unsigned* p, unsigned v) { return __hip_atomic_fetch_add(p, v, __ATOMIC_RELAXED, __HIP_MEMORY_SCOPE_AGENT); }
__device__ __forceinline__ unsigned xb_xcc_id() { return (unsigned)__builtin_amdgcn_s_getreg((3 << 11) | 20) & 0xFu; }
#define XB_SPIN(cond, bar) do { unsigned _sp = 0; while (cond) { __builtin_amdgcn_s_sleep(1); \
    if ((++_sp & 255u) == 0u) { if (xb_ld(&(bar)[XB_TMO])) break; if (_sp > XB_SPIN_CAP) { atomicAdd(&(bar)[XB_TMO], 1u); break; } } } } while (0)

struct XcdBarrier {
    unsigned* bar; unsigned x;
    volatile LAS unsigned* st;
};

__device__ __forceinline__ XcdBarrier xcd_barrier_post(unsigned* bar, volatile LAS unsigned* st) {
    XcdBarrier b; b.bar = bar; b.x = xb_xcc_id(); b.st = st;
    if (threadIdx.x == 0) (void)xb_add(&bar[XB_XCNT(b.x)], 1u);
    return b;
}
__device__ __forceinline__ void xcd_barrier_complete(unsigned* bar, unsigned x, unsigned& nloc, unsigned& nx) {
    const unsigned G = gridDim.x * gridDim.y * gridDim.z;
    unsigned sum, cnt, mine, sp = 0u;
    for (;;) {
        sum = 0u; cnt = 0u; mine = 0u;
#pragma unroll
        for (unsigned j = 0; j < 16; ++j) { const unsigned c = xb_ld(&bar[XB_XCNT(j)]); sum += c; cnt += (c > 0u) ? 1u : 0u; mine = (j == x) ? c : mine; }
        if (sum == G) break;
        __builtin_amdgcn_s_sleep(1);
        if ((++sp & 255u) == 0u) { if (xb_ld(&bar[XB_TMO])) break; if (sp > XB_SPIN_CAP) { atomicAdd(&bar[XB_TMO], 1u); break; } }
    }
    nloc = mine > 0u ? mine : 1u; nx = cnt > 0u ? cnt : 1u;
}

__device__ __forceinline__ void xcd_barrier(const XcdBarrier& b) {
    asm volatile("s_waitcnt vmcnt(0)" ::: "memory");
    __syncthreads();
    if (threadIdx.x == 0) {
        unsigned* bar = b.bar;
        __builtin_amdgcn_s_waitcnt(0);
        unsigned nloc = b.st[0], nx = b.st[1];
        if (nloc == 0u) { xcd_barrier_complete(bar, b.x, nloc, nx); b.st[0] = nloc; b.st[1] = nx; }
        const unsigned old = xb_add(&bar[XB_XSUB(b.x)], 1u);
        const unsigned gen = old / nloc;
        if (old + 1u == (gen + 1u) * nloc) {
            __builtin_amdgcn_fence(__ATOMIC_RELEASE, "agent");
            asm volatile("s_waitcnt vmcnt(0)" ::: "memory");
            const unsigned og = xb_add(&bar[XB_TOP], 1u);
            const unsigned tg = og / nx;
            if (og + 1u == (tg + 1u) * nx) xb_add(&bar[XB_TOPGEN], 1u);
            else XB_SPIN(xb_ld(&bar[XB_TOPGEN]) == tg, bar);
            __builtin_amdgcn_fence(__ATOMIC_ACQUIRE, "agent");
            xb_add(&bar[XB_XGEN(b.x)], 1u);
            asm volatile("s_waitcnt vmcnt(0)" ::: "memory");
        } else {
            XB_SPIN(xb_ld(&bar[XB_XGEN(b.x)]) == gen, bar);
            __builtin_amdgcn_fence(__ATOMIC_ACQUIRE, "agent");
            asm volatile("s_waitcnt vmcnt(0)" ::: "memory");
        }
    }
    __syncthreads();
}


enum { MAT_W13 = 0, MAT_L8 = 1, MAT_WIN = 2, MAT_WUQ = 3 };
__host__ __device__ inline int l8(int j) { const int t = j >> 8, jj = j & 255, bj = jj >> 7, wc = (jj >> 5) & 3, n = (jj >> 4) & 1, fq = (jj >> 2) & 3, e = jj & 3; return t * 256 + 128 * bj + 32 * wc + 8 * fq + 4 * n + e; }
__host__ __device__ inline int map_src(int mat, int j) {
    const int t = j >> 8, jj = j & 255, bj = jj >> 7, wc = (jj >> 5) & 3, n = (jj >> 4) & 1, fq = (jj >> 2) & 3, e = jj & 3;
    switch (mat) {
    case MAT_W13: return bj * D_FF + 128 * t + 32 * wc + 8 * fq + 4 * n + e;
    case MAT_L8: return l8(j);
    case MAT_WIN:
        if (t < 4) return l8(j);
        if (t < 12) { const int base = t < 8 ? CO_RQ : CO_RK, head = 2 * ((t - 4) & 3) + (wc >> 1), idx = 32 * (wc & 1) + 8 * fq + 4 * bj + e; return base + head * 128 + 64 * n + idx; }
        if (t < 44) return CO_RV + l8(j - 12 * 256);
        return (bj == 0 && wc < 2) ? CO_KR + 32 * n + 16 * wc + 4 * fq + e : -1;
    default:
        if (t < 4) { const int f = 128 * bj + 32 * wc + 8 * fq + 4 * n + e; return (2 * t + (f >> 7)) * 192 + (f & 127); }
        { const int head = 4 * (t - 4) + wc, idx = 8 * fq + 4 * bj + e; return head * 192 + 128 + 32 * n + idx; }
    }
}
constexpr int NT_W13 = 11264, NT_WIN = 11520, NT_WUQ = 1536;
constexpr size_t WT_W13A = 0, WT_W2A = WT_W13A + (size_t)NT_W13 * 2048 * 2, WT_WIN = WT_W2A + (size_t)2048 * D_FF * 2, WT_WUQ = WT_WIN + (size_t)NT_WIN * 2048 * 2,
                 WT_WUKV = WT_WUQ + (size_t)NT_WUQ * 512 * 2, WT_W67 = WT_WUKV + (size_t)2048 * 512 * 2, WT_WOUT = WT_W67 + (size_t)2048 * 3072 * 2, WT_W13B = WT_WOUT + (size_t)2048 * 2048 * 2,
                 WT_W2B = WT_W13B + (size_t)NT_W13 * 2048 * 2, WT_BYTES = WT_W2B + (size_t)2048 * D_FF * 2;
constexpr int NI_W13 = 16 * (NT_W13 / 32), NI_W2 = 44 * 64, NI_WIN = 16 * (NT_WIN / 32), NI_WUQ = 4 * (NT_WUQ / 32), NI_WUKV = 4 * 64, NI_W67 = 24 * 64, NI_WOUT = 16 * 64;
constexpr int NI_LAYER = 2 * NI_W13 + 2 * NI_W2 + NI_WIN + NI_WUQ + NI_WUKV + NI_W67 + NI_WOUT;

__device__ __forceinline__ unsigned f2bf_u(float f) { unsigned u = __builtin_bit_cast(unsigned, f); return (u + 0x7fffu + ((u >> 16) & 1u)) >> 16; }
__device__ __forceinline__ unsigned pk2(float lo, float hi) { typedef float f2_t __attribute__((ext_vector_type(2))); typedef __bf16 b2_t __attribute__((ext_vector_type(2))); f2_t v = {lo, hi}; return __builtin_bit_cast(unsigned, __builtin_convertvector(v, b2_t)); }
__device__ __forceinline__ float wave_sum(float v) {
#pragma unroll
    for (int o = 1; o < 64; o <<= 1) v += __shfl_xor(v, o);
    return v;
}
__device__ __forceinline__ void conv_item(const float* W, int ldw, const float* gain, int k0, int src4, bf16* BtRow0, int Kbt, int dst_step, LAS float* scr, int lane) {
    const int jl = lane & 7, kr = lane >> 3;
    f32x4 v[16];
#pragma unroll
    for (int i = 0; i < 16; ++i) { const int kk = kr + 8 * i; v[i] = src4 >= 0 ? *(const f32x4*)(W + (size_t)(k0 + kk) * ldw + src4) : (f32x4){0.f, 0.f, 0.f, 0.f}; }
#pragma unroll
    for (int h = 0; h < 2; ++h) {
#pragma unroll
        for (int i = 0; i < 8; ++i) { const int kk = kr + 8 * i; const float g = gain ? gain[k0 + 64 * h + kk] : 1.f; LAS float* d = scr + kk * 33 + 4 * jl; d[0] = v[8 * h + i][0] * g; d[1] = v[8 * h + i][1] * g; d[2] = v[8 * h + i][2] * g; d[3] = v[8 * h + i][3] * g; }
        LDS_WAIT(); asm volatile("" ::: "memory");
        const int c = lane & 7;
#pragma unroll
        for (int j = 0; j < 4; ++j) { const int n = (lane >> 3) + 8 * j; const LAS float* sp = scr + (8 * c) * 33 + n;
            v4u o; o.x = pk2(sp[0 * 33], sp[1 * 33]); o.y = pk2(sp[2 * 33], sp[3 * 33]); o.z = pk2(sp[4 * 33], sp[5 * 33]); o.w = pk2(sp[6 * 33], sp[7 * 33]);
            *(GAS v4u*)(BtRow0 + (size_t)h * dst_step + (size_t)n * Kbt + 8 * c) = o; }
        LDS_WAIT(); asm volatile("" ::: "memory");
    }
}
struct LayerW { const float *f1n, *f1w13, *f1w2, *mixn, *win, *qn, *kvn, *wuq, *wuk, *wuv, *wmo, *wro, *wout, *f2n, *f2w13, *f2w2; };
__device__ __forceinline__ void conv_dispatch(const LayerW& w, unsigned char* wt, int it, LAS float* scr, int lane) {
    int r = it; const int jl = 4 * (lane & 7);
    if (r < NI_W13) { const int kb = r / 352, j0 = 32 * (r % 352); conv_item(w.f1w13, 2 * D_FF, w.f1n, 128 * kb, map_src(MAT_W13, j0 + jl), (bf16*)(wt + WT_W13A) + (size_t)j0 * 2048 + 128 * kb, 2048, 64, scr, lane); return; } r -= NI_W13;
    if (r < NI_W2) { const int kb = r / 64, j0 = 32 * (r % 64); conv_item(w.f1w2, 2048, nullptr, 128 * kb, l8(j0 + jl), (bf16*)(wt + WT_W2A) + ((size_t)((j0 >> 8) * 88 + 2 * kb) * 256 + (j0 & 255)) * 64, 64, 256 * 64, scr, lane); return; } r -= NI_W2;
    if (r < NI_WIN) { const int kb = r / 360, j0 = 32 * (r % 360); conv_item(w.win, IN_WIDTH, w.mixn, 128 * kb, map_src(MAT_WIN, j0 + jl), (bf16*)(wt + WT_WIN) + (size_t)j0 * 2048 + 128 * kb, 2048, 64, scr, lane); return; } r -= NI_WIN;
    if (r < NI_WUQ) { const int kb = r / 48, j0 = 32 * (r % 48); conv_item(w.wuq, 1536, w.qn, 128 * kb, map_src(MAT_WUQ, j0 + jl), (bf16*)(wt + WT_WUQ) + (size_t)j0 * 512 + 128 * kb, 512, 64, scr, lane); return; } r -= NI_WUQ;
    if (r < NI_WUKV) { const int kb = r / 64, j0 = 32 * (r % 64); const bool isv = j0 >= 1024;
        conv_item(isv ? w.wuv : w.wuk, 1024, w.kvn, 128 * kb, l8((j0 & 1023) + jl), (bf16*)(wt + WT_WUKV) + (size_t)j0 * 512 + 128 * kb, 512, 64, scr, lane); return; } r -= NI_WUKV;
    if (r < NI_W67) { const int kb = r / 64, j0 = 32 * (r % 64); const bool isr = kb >= 8;
        conv_item(isr ? w.wro : w.wmo, 2048, nullptr, isr ? 128 * (kb - 8) : 128 * kb, l8(j0 + jl), (bf16*)(wt + WT_W67) + (size_t)j0 * 3072 + 128 * kb, 3072, 64, scr, lane); return; } r -= NI_W67;
    if (r < NI_WOUT) { const int kb = r / 64, j0 = 32 * (r % 64); conv_item(w.wout, 2048, nullptr, 128 * kb, l8(j0 + jl), (bf16*)(wt + WT_WOUT) + (size_t)j0 * 2048 + 128 * kb, 2048, 64, scr, lane); return; } r -= NI_WOUT;
    if (r < NI_W13) { const int kb = r / 352, j0 = 32 * (r % 352); conv_item(w.f2w13, 2 * D_FF, w.f2n, 128 * kb, map_src(MAT_W13, j0 + jl), (bf16*)(wt + WT_W13B) + (size_t)j0 * 2048 + 128 * kb, 2048, 64, scr, lane); return; } r -= NI_W13;
    { const int kb = r / 64, j0 = 32 * (r % 64); conv_item(w.f2w2, 2048, nullptr, 128 * kb, l8(j0 + jl), (bf16*)(wt + WT_W2B) + ((size_t)((j0 >> 8) * 88 + 2 * kb) * 256 + (j0 & 255)) * 64, 64, 256 * 64, scr, lane); }
}

template <int NSL> __device__ __forceinline__ void finalize_res(unsigned char* ws, float scale, int gw, int NGW) {
    const int lane = fresh_lane(); bf16* XB = (bf16*)(ws + WS_XB); float* SS = (float*)(ws + WS_SS); const float* slab = (const float*)(ws + WS_SLAB);
    for (int it = gw; it < MS * 8; it += NGW) { const int r = it >> 3, j = it & 7, c = 256 * j + 4 * lane; const size_t row = (size_t)MP + r;
        f32x4 acc = {0.f, 0.f, 0.f, 0.f};
        const uint2 xb = *(const uint2*)(XB + row * 2048 + c);
        f32x4 sl[NSL];
#pragma unroll
        for (int ks = 0; ks < NSL; ++ks) sl[ks] = *(const f32x4*)(slab + ((size_t)ks * MS + r) * 2048 + c);
#pragma unroll
        for (int ks = 0; ks < NSL; ++ks) acc += sl[ks];
        const f32x4 x = {__uint_as_float(xb.x << 16), __uint_as_float(xb.x & 0xffff0000u), __uint_as_float(xb.y << 16), __uint_as_float(xb.y & 0xffff0000u)};
        const f32x4 v = x + acc * scale;
        uint2 o; o.x = pk2(v[0], v[1]); o.y = pk2(v[2], v[3]); *(uint2*)(XB + row * 2048 + c) = o;
        const float s = wave_sum((v[0] * v[0] + v[1] * v[1]) + (v[2] * v[2] + v[3] * v[3]));
        if (lane < 4) SS[row * 32 + 4 * j + lane] = lane == 0 ? s : 0.f; }
}
__device__ __forceinline__ void finalize_gate(unsigned char* ws, int gw, int NGW) {
    const int lane = fresh_lane(); bf16* GM = (bf16*)(ws + WS_GM); const bf16* GR = (const bf16*)(ws + WS_GR); const float* slab = (const float*)(ws + WS_SLAB);
    for (int it = gw; it < MS * 8; it += NGW) { const int r = it >> 3, c = 256 * (it & 7) + 4 * lane; const size_t row = (size_t)MP + r;
        f32x4 p1 = {0.f, 0.f, 0.f, 0.f}, p2 = {0.f, 0.f, 0.f, 0.f};
#pragma unroll
        for (int ks = 0; ks < 4; ++ks) p1 += *(const f32x4*)(slab + ((size_t)ks * MS + r) * 2048 + c);
#pragma unroll
        for (int ks = 4; ks < 12; ++ks) p2 += *(const f32x4*)(slab + ((size_t)ks * MS + r) * 2048 + c);
        const uint2 gm = *(const uint2*)(GM + row * 2048 + c), gr = *(const uint2*)(GR + row * 2048 + c);
        const f32x4 a = {__uint_as_float(gm.x << 16), __uint_as_float(gm.x & 0xffff0000u), __uint_as_float(gm.y << 16), __uint_as_float(gm.y & 0xffff0000u)};
        const f32x4 b = {__uint_as_float(gr.x << 16), __uint_as_float(gr.x & 0xffff0000u), __uint_as_float(gr.y << 16), __uint_as_float(gr.y & 0xffff0000u)};
        const f32x4 v = a * p1 + b * p2; uint2 o; o.x = pk2(v[0], v[1]); o.y = pk2(v[2], v[3]); *(uint2*)(GM + row * 2048 + c) = o; }
}
enum Phase { PH_CONV = 0, PH_UP1, PH_DOWN1, PH_DOWN1F, PH_WIN, PH_QKV, PH_MIX, PH_MR, PH_MRF, PH_OUT, PH_OUTF, PH_UP2, PH_DOWN2, PH_DOWN2F, PH_PER_LAYER };
struct Args { const float* in[22]; float* out; unsigned char* ws; int l_lo, l_hi, ph_lo, ph_hi, fused, do_final; };

__global__ void __launch_bounds__(NWAVES * 64, 2) mk_fwd(Args a) {
    extern __shared__ __attribute__((aligned(16))) unsigned char lds[];
    LAS unsigned char* L = (LAS unsigned char*)lds;
    volatile LAS unsigned* MISC = (volatile LAS unsigned*)(L + MISC_OFF);
    const int wave = __builtin_amdgcn_readfirstlane((int)threadIdx.x >> 6);
    const int G = gridDim.x, bx = blockIdx.x, vcu = (G % 8 == 0) ? (bx % 8) * (G / 8) + bx / 8 : bx;
    const int gw = vcu * NWAVES + wave, NGW = G * NWAVES;
    unsigned char* ws = a.ws; unsigned* ctl = (unsigned*)(ws + WS_CTL);
    for (int u = threadIdx.x; u < (LDS_BYTES - LDSCTL_OFF) / 4; u += NWAVES * 64) ((LAS unsigned*)(L + LDSCTL_OFF))[u] = 0u;
    __syncthreads();
    XcdBarrier bar; bar.bar = ctl + CW_BAR; bar.x = 0; bar.st = nullptr;
    if (a.fused) bar = xcd_barrier_post(ctl + CW_BAR, MISC + 8);
#define SEAM() do { if (a.fused) xcd_barrier(bar); } while (0)
#define IN(k) (a.ph_lo <= (k) && (k) < a.ph_hi)
    unsigned char* wt = ws + WS_WT;
    if (IN(PH_CONV) && a.l_lo == 0 && a.l_hi > 0) {
        const int lane = fresh_lane(), tid = wave * 64 + lane;
        float* SS = (float*)(ws + WS_SS); bf16* XB = (bf16*)(ws + WS_XB); float2* t64 = (float2*)(ws + WS_ROPE64); float2* t128 = (float2*)(ws + WS_ROPE128);
        for (int m = gw; m < MT; m += NGW) {
            const float* xr = m < MP ? a.in[0] + (size_t)m * 2048 : a.in[1] + (size_t)(m - MP) * 2048; float s = 0.f; f32x4 xv[8];
#pragma unroll
            for (int j = 0; j < 8; ++j) xv[j] = *(const f32x4*)(xr + 256 * j + 4 * lane);
#pragma unroll
            for (int j = 0; j < 8; ++j) { const f32x4 v = xv[j];
                uint2 o; o.x = pk2(v[0], v[1]); o.y = pk2(v[2], v[3]); *(uint2*)(XB + (size_t)m * 2048 + 256 * j + 4 * lane) = o; s += (v[0] * v[0] + v[1] * v[1]) + (v[2] * v[2] + v[3] * v[3]); }
            s = wave_sum(s); if (lane < 32) SS[(size_t)m * 32 + lane] = lane == 0 ? s : 0.f;
        }
        for (int i = bx * 512 + tid; i < 4096 * 64; i += G * 512) {
            { const int pos = i / 64, j = i % 64; const double inv = pow(10000.0, -(2.0 * j) / 128.0), ang = (double)pos * inv; t128[i] = make_float2((float)cos(ang), (float)sin(ang)); }
            if (i < 4096 * 32) { const int pos = i / 32, j = i % 32; const double inv = pow(10000.0, -(2.0 * j) / 64.0), ang = (double)pos * inv; t64[i] = make_float2((float)cos(ang), (float)sin(ang)); }
        }
    }
    for (int l = a.l_lo; l < a.l_hi; ++l) {
        if (IN(PH_CONV)) {
            LayerW w; w.f1n = a.in[5] + (size_t)l * 2048; w.f1w13 = a.in[6] + (size_t)l * 2048 * 2 * D_FF; w.f1w2 = a.in[7] + (size_t)l * D_FF * 2048; w.mixn = a.in[8] + (size_t)l * 2048; w.win = a.in[9] + (size_t)l * 2048 * IN_WIDTH;
            w.qn = a.in[10] + (size_t)l * 512; w.kvn = a.in[11] + (size_t)l * 512; w.wuq = a.in[12] + (size_t)l * 512 * 1536; w.wuk = a.in[13] + (size_t)l * 512 * 1024; w.wuv = a.in[14] + (size_t)l * 512 * 1024;
            w.wmo = a.in[15] + (size_t)l * 1024 * 2048; w.wro = a.in[16] + (size_t)l * 2048 * 2048; w.wout = a.in[17] + (size_t)l * 2048 * 2048; w.f2n = a.in[18] + (size_t)l * 2048; w.f2w13 = a.in[19] + (size_t)l * 2048 * 2 * D_FF; w.f2w2 = a.in[20] + (size_t)l * D_FF * 2048;
            LAS float* scr = (LAS float*)(L + RING_OFF + wave * 16384); const int lane = fresh_lane();
            for (int it = gw; it < NI_LAYER; it += NGW) conv_dispatch(w, wt, it, scr, lane);
            {
                const float* cc = a.in[2] + (size_t)l * DEC_BATCH * PAST_LEN * 512; const float* ck = a.in[3] + (size_t)l * DEC_BATCH * PAST_LEN * 64; bf16* CALL = (bf16*)(ws + WS_CALL);
                int i0 = gw;
                for (; i0 + 3 * NGW < DEC_BATCH * PAST_LEN; i0 += 4 * NGW) {
                    const float* c = cc + (size_t)i0 * 512 + 8 * lane; const float* k = ck + (size_t)i0 * 64 + lane; const size_t cs = (size_t)NGW * 512, ks = (size_t)NGW * 64;
                    const f32x4 a0 = *(const f32x4*)c, a1 = *(const f32x4*)(c + 4), b0 = *(const f32x4*)(c + cs), b1 = *(const f32x4*)(c + cs + 4), c0 = *(const f32x4*)(c + 2 * cs), c1 = *(const f32x4*)(c + 2 * cs + 4), d0 = *(const f32x4*)(c + 3 * cs), d1 = *(const f32x4*)(c + 3 * cs + 4);
                    const float ka = k[0], kb = k[ks], kc = k[2 * ks], kd = k[3 * ks];
#define CALL_ROW(i, x0, x1, kx) { bf16* dst = CALL + ((size_t)((i) >> 11) * 2112 + ((i) & 2047)) * 576; v4u o; o.x = pk2(x0[0], x0[1]); o.y = pk2(x0[2], x0[3]); o.z = pk2(x1[0], x1[1]); o.w = pk2(x1[2], x1[3]); *(v4u*)(dst + 8 * lane) = o; dst[512 + lane] = (bf16)f2bf_u(kx); }
                    CALL_ROW(i0, a0, a1, ka) CALL_ROW(i0 + NGW, b0, b1, kb) CALL_ROW(i0 + 2 * NGW, c0, c1, kc) CALL_ROW(i0 + 3 * NGW, d0, d1, kd)
                }
                for (; i0 < DEC_BATCH * PAST_LEN; i0 += NGW) { const float* c = cc + (size_t)i0 * 512 + 8 * lane; const f32x4 a0 = *(const f32x4*)c, a1 = *(const f32x4*)(c + 4); const float ka = ck[(size_t)i0 * 64 + lane]; CALL_ROW(i0, a0, a1, ka) }
#undef CALL_ROW
                for (int i = gw; i < DEC_BATCH * 48; i += NGW) { bf16* dst = CALL + ((size_t)(i / 48) * 2112 + PAST_LEN + DEC_SEQ + i % 48) * 576;
                    unsigned z = 0u; asm volatile("" : "+v"(z)); *(v4u*)(dst + 8 * lane) = (v4u){z, z, z, z}; dst[512 + lane] = (bf16)z; }
            }
            SEAM();
        }
        for (int half = 0; half < 2; ++half) {
            if (IN(half ? PH_UP2 : PH_UP1)) { pg8::Gemm g{(const bf16*)(ws + WS_XB), (const bf16*)(wt + (half ? WT_W13B : WT_W13A)), MT, NT_W13, 2048, 2048, 2048}; pg8::StaticOrder S; S.init(MT, NT_W13, G, bx); pg8::EpiUp E{ws};
                pg8::gemm_phase<pg8::EpiUp, pg8::StaticOrder, true, true>(L + RING_OFF, g, S, E, wave); SEAM(); }
            if (IN(half ? PH_DOWN2 : PH_DOWN1)) {
                { pg8::Gemm g{(const bf16*)(ws + WS_HB), (const bf16*)(wt + (half ? WT_W2B : WT_W2A)), MP, 2048, D_FF, 64, 64, 32768, (size_t)(D_FF / 64) * 32768, 32768, (size_t)(D_FF / 64) * 32768}; pg8::StaticOrder S; S.init(MP, 2048, G, bx); pg8::EpiRes E{ws, 0.5f};
                  pg8::gemm_phase<pg8::EpiRes, pg8::StaticOrder, true, true>(L + RING_OFF, g, S, E, wave); }
                { pg8::Gemm g{(const bf16*)(ws + WS_HB) + (size_t)MP * D_FF, (const bf16*)(wt + (half ? WT_W2B : WT_W2A)), MS, 2048, 512, 64, 64, 32768, (size_t)(D_FF / 64) * 32768, 32768, (size_t)(D_FF / 64) * 32768}; pg8::SplitOrder S; S.init(2048, 11, 512, G, bx); pg8::EpiSlab E{(float*)(ws + WS_SLAB), 0, 512};
                  pg8::gemm_phase<pg8::EpiSlab, pg8::SplitOrder, true, true>(L + RING_OFF, g, S, E, wave); }
                SEAM();
            }
            if (IN(half ? PH_DOWN2F : PH_DOWN1F)) { finalize_res<11>(ws, 0.5f, gw, NGW); SEAM(); }
            if (half == 0) {
            if (IN(PH_WIN)) { pg8::Gemm g{(const bf16*)(ws + WS_XB), (const bf16*)(wt + WT_WIN), MT, NT_WIN, 2048, 2048, 2048}; pg8::StaticOrder S; S.init(MT, NT_WIN, G, bx);
                pg8::EpiWin E{ws, a.out, l};
                pg8::gemm_phase<pg8::EpiWin, pg8::StaticOrder, true, true>(L + RING_OFF, g, S, E, wave); SEAM(); }
            if (IN(PH_QKV)) {
                { pg8::Gemm g{(const bf16*)(ws + WS_QL), (const bf16*)(wt + WT_WUQ), MT, NT_WUQ, 512, 512, 512}; pg8::StaticOrder S; S.init(MT, NT_WUQ, G, bx); pg8::EpiQ E{ws};
                  pg8::gemm_phase<pg8::EpiQ, pg8::StaticOrder, true, true>(L + RING_OFF, g, S, E, wave); }
                { pg8::Gemm g{(const bf16*)(ws + WS_CRB), (const bf16*)(wt + WT_WUKV), MP, 2048, 512, 512, 512}; pg8::StaticOrder S; S.init(MP, 2048, G, bx); pg8::EpiKV E{ws};
                  pg8::gemm_phase<pg8::EpiKV, pg8::StaticOrder, true, true>(L + RING_OFF, g, S, E, wave); }
                for (int u = bx; u < 32 * mix::RT_NSEG; u += G) mix::ret_unit<0>((MLAS char*)(L + RING_OFF), ws, a.out + OFF_Y, nullptr, u >> 6, (u >> 3) & 7, u & 7, wave);
                const int lane = fresh_lane(); const float* SC = (const float*)(ws + WS_SC); const bf16* CRB = (const bf16*)(ws + WS_CRB); const float* kvn = a.in[11] + (size_t)l * 512;
                int m = gw;
                for (; m + 3 * NGW < MP; m += 4 * NGW) {
                    f32x4 sa[4], sb[4]; uint2 cb[4][2];
#pragma unroll
                    for (int q = 0; q < 4; ++q) { const size_t mm = (size_t)m + (size_t)q * NGW; sa[q] = *(const f32x4*)(SC + mm * 8); sb[q] = *(const f32x4*)(SC + mm * 8 + 4); cb[q][0] = *(const uint2*)(CRB + mm * 512 + 4 * lane); cb[q][1] = *(const uint2*)(CRB + mm * 512 + 256 + 4 * lane); }
                    const f32x4 kv0 = *(const f32x4*)(kvn + 4 * lane), kv1 = *(const f32x4*)(kvn + 256 + 4 * lane);
#pragma unroll
                    for (int q = 0; q < 4; ++q) { const size_t mm = (size_t)m + (size_t)q * NGW;
                        const float rstd = rsqrtf((((sa[q][0] + sa[q][1]) + (sa[q][2] + sa[q][3])) + ((sb[q][0] + sb[q][1]) + (sb[q][2] + sb[q][3]))) * (1.f / 512.f) + NORM_EPS);
                        float* co = a.out + OFF_CKVP + ((size_t)l * MP + mm) * 512;
#pragma unroll
                        for (int j = 0; j < 2; ++j) { const uint2 c2 = cb[q][j]; const f32x4 cr = {__uint_as_float(c2.x << 16), __uint_as_float(c2.x & 0xffff0000u), __uint_as_float(c2.y << 16), __uint_as_float(c2.y & 0xffff0000u)};
                            *(f32x4*)(co + 256 * j + 4 * lane) = cr * rstd * (j ? kv1 : kv0); } }
                }
                for (; m < MT; m += NGW) {
                    const f32x4 s0 = *(const f32x4*)(SC + (size_t)m * 8), s1 = *(const f32x4*)(SC + (size_t)m * 8 + 4);
                    const float rstd = rsqrtf((((s0[0] + s0[1]) + (s0[2] + s0[3])) + ((s1[0] + s1[1]) + (s1[2] + s1[3]))) * (1.f / 512.f) + NORM_EPS);
                    float* co = m < MP ? a.out + OFF_CKVP + ((size_t)l * MP + m) * 512 : a.out + OFF_CKVS + ((size_t)l * MS + (m - MP)) * 512;
#pragma unroll
                    for (int j = 0; j < 2; ++j) { const int c = 256 * j + 4 * lane; const uint2 cb = *(const uint2*)(CRB + (size_t)m * 512 + c);
                    const f32x4 cr = {__uint_as_float(cb.x << 16), __uint_as_float(cb.x & 0xffff0000u), __uint_as_float(cb.y << 16), __uint_as_float(cb.y & 0xffff0000u)}; const f32x4 v = cr * rstd * *(const f32x4*)(kvn + c);
                        *(f32x4*)(co + c) = v; uint2 o; o.x = pk2(v[0], v[1]); o.y = pk2(v[2], v[3]);
                        if (m >= MP) *(uint2*)((bf16*)(ws + WS_CALL) + ((size_t)((m - MP) >> 4) * 2112 + PAST_LEN + ((m - MP) & 15)) * 576 + c) = o; }
                    if (m >= MP) ((bf16*)(ws + WS_CALL))[((size_t)((m - MP) >> 4) * 2112 + PAST_LEN + ((m - MP) & 15)) * 576 + 512 + lane] = ((const bf16*)(ws + WS_KR))[(size_t)m * 64 + lane];
                }
                SEAM();
            }
            if (IN(PH_MIX)) {
                const int xq = bx & 7;
                for (;;) {
                    __syncthreads();
                    if (threadIdx.x == 0) MISC[16] = __hip_atomic_fetch_add(ctl + CW_QUEUE + 64 * l + xq, 1u, __ATOMIC_RELAXED, __HIP_MEMORY_SCOPE_AGENT);
                    __syncthreads();
                    int t = (int)MISC[16];
                    if (t >= 4 + 32 + 8 + 64) break;
                    if (t < 4) { const int id = 4 * xq + t; mix::sample_attn_unit((MLAS char*)(L + RING_OFF), ws, a.in[13] + (size_t)l * 512 * 1024, a.in[14] + (size_t)l * 512 * 1024, id >> 1, id & 1, wave); }
                    else if (t < 36) { t -= 4; const int p = 4 * xq + (t >> 3), seg = t & 7; mix::ret_unit<1>((MLAS char*)(L + RING_OFF), ws, a.out + OFF_Y, a.out + OFF_RETP + ((size_t)l * 32 + p) * 32768, p >> 3, p & 7, seg, wave); }
                    else if (t < 44) { t = 8 * xq + (t - 36); const int hf = wave >> 2, tt = (wave & 3) * 64 + fresh_lane(); MLAS float* Lh = (MLAS float*)(L + RING_OFF) + hf * 4352;
                        mix::sample_ret_item(Lh, ws, a.in[4] + (size_t)l * DEC_BATCH * 8 * 128 * 256, a.out + OFF_RETS + (size_t)l * DEC_BATCH * 8 * 128 * 256, 2 * t + hf, tt); }
                    else { t -= 44; const int p = 4 * xq + (t & 3); mix::attn_unit((MLAS char*)(L + RING_OFF), ws, p >> 3, p & 7, 15 - (t >> 2), wave); }
                }
                SEAM();
            }
            if (IN(PH_MR)) {
                { pg8::Gemm g{(const bf16*)(ws + WS_AR), (const bf16*)(wt + WT_W67), MP, 2048, 1024, 3072, 3072}; pg8::StaticOrder S; S.init(MP, 2048, G, bx); pg8::EpiGate<0> E{ws};
                  pg8::gemm_phase<pg8::EpiGate<0>, pg8::StaticOrder, true, true>(L + RING_OFF, g, S, E, wave); }
                { pg8::Gemm g{(const bf16*)(ws + WS_AR) + 1024, (const bf16*)(wt + WT_W67) + 1024, MP, 2048, 2048, 3072, 3072}; pg8::StaticOrder S; S.init(MP, 2048, G, bx); pg8::EpiGate<1> E{ws};
                  pg8::gemm_phase<pg8::EpiGate<1>, pg8::StaticOrder, true, true>(L + RING_OFF, g, S, E, wave); }
                { pg8::Gemm g{(const bf16*)(ws + WS_AR) + (size_t)MP * 3072, (const bf16*)(wt + WT_W67), MS, 2048, 256, 3072, 3072}; pg8::SplitOrder S; S.init(2048, 4, 256, G, bx); pg8::EpiSlab E{(float*)(ws + WS_SLAB), 0, 256};
                  pg8::gemm_phase<pg8::EpiSlab, pg8::SplitOrder, true, true>(L + RING_OFF, g, S, E, wave); }
                { pg8::Gemm g{(const bf16*)(ws + WS_AR) + (size_t)MP * 3072 + 1024, (const bf16*)(wt + WT_W67) + 1024, MS, 2048, 256, 3072, 3072}; pg8::SplitOrder S; S.init(2048, 8, 256, G, (bx + G - 32 % G) % G); pg8::EpiSlab E{(float*)(ws + WS_SLAB), 4, 256};
                  pg8::gemm_phase<pg8::EpiSlab, pg8::SplitOrder, true, true>(L + RING_OFF, g, S, E, wave); }
                SEAM();
            }
            if (IN(PH_MRF)) { finalize_gate(ws, gw, NGW); SEAM(); }
            if (IN(PH_OUT)) {
                { pg8::Gemm g{(const bf16*)(ws + WS_GM), (const bf16*)(wt + WT_WOUT), MP, 2048, 2048, 2048, 2048}; pg8::StaticOrder S; S.init(MP, 2048, G, bx); pg8::EpiRes E{ws, 1.0f};
                  pg8::gemm_phase<pg8::EpiRes, pg8::StaticOrder, true, true>(L + RING_OFF, g, S, E, wave); }
                { pg8::Gemm g{(const bf16*)(ws + WS_GM) + (size_t)MP * 2048, (const bf16*)(wt + WT_WOUT), MS, 2048, 256, 2048, 2048}; pg8::SplitOrder S; S.init(2048, 8, 256, G, bx); pg8::EpiSlab E{(float*)(ws + WS_SLAB), 0, 256};
                  pg8::gemm_phase<pg8::EpiSlab, pg8::SplitOrder, true, true>(L + RING_OFF, g, S, E, wave); }
                SEAM();
            }
            if (IN(PH_OUTF)) { finalize_res<8>(ws, 1.0f, gw, NGW); SEAM(); }
            }
        }
    }
    if (a.do_final) {
        const int lane = fresh_lane();
        const float* fg = a.in[21]; const bf16* XB = (const bf16*)(ws + WS_XB); const float* SS = (const float*)(ws + WS_SS);
        f32x4 fgv[8];
#pragma unroll
        for (int j = 0; j < 8; ++j) fgv[j] = *(const f32x4*)(fg + 256 * j + 4 * lane);
        for (int m = gw; m < MT; m += NGW) { const float sl = lane < 32 ? SS[(size_t)m * 32 + lane] : 0.f; uint2 xr[8];
#pragma unroll
            for (int j = 0; j < 8; ++j) xr[j] = *(const uint2*)(XB + (size_t)m * 2048 + 256 * j + 4 * lane);
            const float rstd = rsqrtf(wave_sum(sl) * (1.f / 2048.f) + NORM_EPS);
#pragma unroll
            for (int j = 0; j < 8; ++j) { const uint2 xb = xr[j];
                const f32x4 x = {__uint_as_float(xb.x << 16), __uint_as_float(xb.x & 0xffff0000u), __uint_as_float(xb.y << 16), __uint_as_float(xb.y & 0xffff0000u)};
                *(f32x4*)(a.out + OFF_Y + (size_t)m * 2048 + 256 * j + 4 * lane) = x * rstd * fgv[j]; } }
    }
#undef SEAM
#undef IN
}
}

static_assert(mk::WT_BYTES == WT_BYTES_TOTAL, "weight region size");
static int g_grid = 0;
extern "C" void kernel_launch(void* const* d_in, const int* in_sizes, int n_in, void* d_out, int out_size, void* d_ws, size_t ws_size, hipStream_t stream) {
    if (n_in != 22 || (size_t)out_size != OUT_TOTAL || ws_size < WS_END) { fprintf(stderr, "kernel_launch: unexpected shapes (n_in %d out %d ws %zu need %zu)\n", n_in, out_size, ws_size, (size_t)WS_END); return; }
    if (g_grid == 0) {
        int dev = 0, cus = 0;
        if (hipGetDevice(&dev) != hipSuccess || hipDeviceGetAttribute(&cus, hipDeviceAttributeMultiprocessorCount, dev) != hipSuccess) { g_grid = -1; return; }
        if (hipFuncSetAttribute((const void*)mk::mk_fwd, hipFuncAttributeMaxDynamicSharedMemorySize, mk::LDS_BYTES) != hipSuccess) { fprintf(stderr, "kernel_launch: hipFuncSetAttribute failed\n"); g_grid = -1; return; }
        int per_cu = 0; (void)hipOccupancyMaxActiveBlocksPerMultiprocessor(&per_cu, (const void*)mk::mk_fwd, mk::NWAVES * 64, mk::LDS_BYTES); (void)hipGetLastError();
        g_grid = cus;
    }
    if (g_grid < 0) return;
    (void)hipMemsetAsync((char*)d_ws + WS_CTL, 0, 1u << 20, stream);
    mk::Args a{}; for (int i = 0; i < 22; ++i) a.in[i] = (const float*)d_in[i]; a.out = (float*)d_out; a.ws = (unsigned char*)d_ws;
    a.l_lo = 0; a.l_hi = DEPTH; a.ph_lo = 0; a.ph_hi = mk::PH_PER_LAYER; a.fused = 1; a.do_final = 1;
    hipLaunchKernelGGL(mk::mk_fwd, dim3(g_grid), dim3(mk::NWAVES * 64), mk::LDS_BYTES, stream, a);
}
```
